# Optimizing an MI355X kernel written in HIP

```python
import jax, jax.numpy as jnp
from jax import lax
import numpy as np

D_MODEL = 4096
BATCH = 4
SEQ = 2048
DEPTH = 2
DEC_BATCH = 8
DEC_SEQ = 32
PAST_LEN = 4096

CHUNK = 64
D_PLE = 256
EPS = 1e-6
TINY = 1e-30
GLA_H = 4
GLA_DK = 128
GLA_DV = 256
GLA_RANK = 16
GLA_GATE_NORM = 16.0
GDN_H = 16
GDN_DK = 128
GDN_DV = 128
GDN_CONV = 4
HG_H = 8
HG_DK = 128
HG_DV = 128
GLA_KW = GLA_H * GLA_DK
GLA_VW = GLA_H * GLA_DV
GDN_KW = GDN_H * GDN_DK
GDN_VW = GDN_H * GDN_DV
GDN_QKV = 2 * GDN_KW + GDN_VW
HG_KW = HG_H * HG_DK
HG_VW = HG_H * HG_DV
D_MIX = GLA_VW + GDN_VW + HG_VW
D_FF = 11008
FFN_CONV = 3
IN_SPLITS = (GLA_KW, GLA_KW, GLA_VW, GLA_VW, GLA_RANK,
             GDN_QKV, GDN_VW, GDN_H, GDN_H,
             HG_KW, HG_KW, HG_VW, HG_VW)
N_IN = sum(IN_SPLITS)

kernel_name = "hybrid_gla_gdn_hgrn2_stream_step"


def rms_norm(x, w):
    x32 = x.astype(jnp.float32)
    y = x32 * lax.rsqrt(jnp.mean(x32 * x32, axis=-1, keepdims=True) + EPS)
    return (y * w.astype(jnp.float32)).astype(x.dtype)


def l2_norm(x):
    return x * lax.rsqrt(jnp.sum(x * x, axis=-1, keepdims=True) + EPS)


def split_cols(a, sizes):
    out, start = [], 0
    for s in sizes:
        out.append(a[..., start:start + s])
        start += s
    return out


def heads(a, n_heads):
    b, t, _ = a.shape
    return jnp.moveaxis(a.reshape(b, t, n_heads, -1), 2, 1)


def to_chunks(a, chunk):
    b, h, t = a.shape[:3]
    return jnp.moveaxis(a.reshape(b, h, t // chunk, chunk, *a.shape[3:]), 2, 0)


def from_chunks(a):
    n, b, h, c, d = a.shape
    return jnp.moveaxis(a, 0, 2).reshape(b, h, n * c, d)


def masked_exp(mask, diff):
    return jnp.where(mask, jnp.exp(jnp.where(mask, diff, 0.0)), 0.0)


def causal_dwconv(x, buf, w):
    width = w.shape[0]
    t = x.shape[1]
    xp = jnp.concatenate([buf.astype(x.dtype), x], axis=1)
    wx = w.astype(x.dtype)
    y = xp[:, 0:t] * wx[0]
    for j in range(1, width):
        y = y + xp[:, j:j + t] * wx[j]
    return y, xp[:, -(width - 1):]


def gated_head_norm(o, gate, w):
    b, h, t, d = o.shape
    o = o * lax.rsqrt(jnp.mean(o * o, axis=-1, keepdims=True) + EPS) * w.astype(jnp.float32)
    o = jnp.moveaxis(o, 1, 2).reshape(b, t, h * d)
    return (o * jax.nn.silu(gate.astype(jnp.float32))).astype(gate.dtype)


def gated_linear_scan(q, k, v, log_f, state, chunk):
    causal = jnp.tril(jnp.ones((chunk, chunk), dtype=bool))[:, :, None]

    def step(s, inp):
        qc, kc, vc, gc = inp
        b = jnp.cumsum(gc, axis=2)
        decay = masked_exp(causal, b[:, :, :, None, :] - b[:, :, None, :, :])
        attn = jnp.einsum('bhtd,bhsd,bhtsd->bhts', qc, kc, decay)
        o = (jnp.einsum('bhtd,bhde->bhte', qc * jnp.exp(b), s)
             + jnp.einsum('bhts,bhse->bhte', attn, vc))
        b_last = b[:, :, -1, :]
        s = (jnp.exp(b_last)[..., None] * s
             + jnp.einsum('bhsd,bhse->bhde', kc * jnp.exp(b_last[:, :, None, :] - b), vc))
        return s, o

    s, o = lax.scan(step, state, (to_chunks(q, chunk), to_chunks(k, chunk),
                                  to_chunks(v, chunk), to_chunks(log_f, chunk)))
    return from_chunks(o), s


def gated_delta_scan(q, k, v, beta, log_a, state, chunk):
    dv = v.shape[-1]
    causal = jnp.tril(jnp.ones((chunk, chunk), dtype=bool))
    eye = jnp.eye(chunk, dtype=bool)
    strict = causal & ~eye
    eye_f = eye.astype(jnp.float32)

    def step(s, inp):
        qc, kc, vc, bc, gc = inp
        b = jnp.cumsum(gc, axis=-1)
        decay = masked_exp(causal, b[..., :, None] - b[..., None, :])
        kk = jnp.einsum('bhtd,bhsd->bhts', kc, kc)
        a_mat = jnp.where(strict, bc[..., :, None] * kk * decay, 0.0) + eye_f
        rhs = jnp.concatenate([vc * bc[..., None], kc * (bc * jnp.exp(b))[..., None]], axis=-1)
        sol = lax.linalg.triangular_solve(a_mat, rhs, left_side=True, lower=True,
                                          unit_diagonal=True)
        u, w = sol[..., :dv], sol[..., dv:]
        v_new = u - jnp.einsum('bhtd,bhde->bhte', w, s)
        qk = jnp.einsum('bhtd,bhsd->bhts', qc, kc) * decay
        o = (jnp.einsum('bhtd,bhde->bhte', qc * jnp.exp(b)[..., None], s)
             + jnp.einsum('bhts,bhse->bhte', qk, v_new))
        b_last = b[..., -1]
        s = (jnp.exp(b_last)[..., None, None] * s
             + jnp.einsum('bhsd,bhse->bhde', kc * jnp.exp(b_last[..., None] - b)[..., None], v_new))
        return s, o

    s, o = lax.scan(step, state, (to_chunks(q, chunk), to_chunks(k, chunk), to_chunks(v, chunk),
                                  to_chunks(beta, chunk), to_chunks(log_a, chunk)))
    return from_chunks(o), s


def gla_mixer(q, k, v, g, lr, w_gate, b_gate, norm_w, state, chunk):
    f32 = jnp.float32
    log_f = jax.nn.log_sigmoid((lr @ w_gate + b_gate).astype(f32)) / GLA_GATE_NORM
    qh = heads(q.astype(f32), GLA_H) * (GLA_DK ** -0.5)
    o, s = gated_linear_scan(qh, heads(k.astype(f32), GLA_H), heads(v.astype(f32), GLA_H),
                             heads(log_f, GLA_H), state.astype(f32), chunk)
    return gated_head_norm(o, g, norm_w), s


def gdn_mixer(qkv, z, b_raw, a_raw, conv_w, a_log, dt_bias, norm_w, state, conv_buf, chunk):
    f32 = jnp.float32
    qkv, new_buf = causal_dwconv(qkv, conv_buf, conv_w)
    qkv = jax.nn.silu(qkv.astype(f32))
    q, k, v = split_cols(qkv, (GDN_KW, GDN_KW, GDN_VW))
    q = l2_norm(heads(q, GDN_H)) * (GDN_DK ** -0.5)
    k = l2_norm(heads(k, GDN_H))
    v = heads(v, GDN_H)
    beta = jnp.moveaxis(jax.nn.sigmoid(b_raw.astype(f32)), 2, 1)
    log_a = jnp.moveaxis(-jnp.exp(a_log.astype(f32))
                         * jax.nn.softplus(a_raw.astype(f32) + dt_bias.astype(f32)), 2, 1)
    o, s = gated_delta_scan(q, k, v, beta, log_a, state.astype(f32), chunk)
    return gated_head_norm(o, z, norm_w), s, new_buf


def hgrn_mixer(q, f, i, g, lb, norm_w, state, chunk):
    f32 = jnp.float32
    zf = f.astype(f32)
    log_lb = jnp.log(jnp.maximum(lb, TINY))
    log_f = jnp.logaddexp(log_lb, jnp.log1p(-lb) + jax.nn.log_sigmoid(zf))
    key = (1.0 - lb) * jax.nn.sigmoid(-zf)
    qh = heads(jax.nn.silu(q.astype(f32)), HG_H)
    o, s = gated_linear_scan(qh, heads(key, HG_H), heads(i.astype(f32), HG_H),
                             heads(log_f, HG_H), state.astype(f32), chunk)
    return gated_head_norm(o, g, norm_w), s


def trunk(x, pe, st_gla, st_gdn, cb_gdn, st_hg, cb_ffn, params, chunk):
    (norm_mix, w_in, w_gla_gate, b_gla_gate, gla_norm, w_gdn_conv, gdn_a_log, gdn_dt_bias,
     gdn_norm, hgrn_lb, hgrn_norm, w_out, norm_ffn, w_up, w_ffn_conv, w_down, norm_ple,
     w_ple_gate, w_ple_proj, norm_final) = params
    sm = jax.nn.softmax(hgrn_lb.astype(jnp.float32), axis=0)
    lower_bounds = jnp.cumsum(sm, axis=0) - sm[0]
    h = x
    n_gla, n_gdn, n_gconv, n_hg, n_fconv = [], [], [], [], []
    for li in range(DEPTH):
        xn = rms_norm(h, norm_mix[li])
        (gq, gk, gv, gg, glr, dqkv, dz, db, da, hq, hf, hi, hg) = split_cols(xn @ w_in[li], IN_SPLITS)
        o_gla, s_gla = gla_mixer(gq, gk, gv, gg, glr, w_gla_gate[li], b_gla_gate[li],
                                 gla_norm[li], st_gla[li], chunk)
        o_gdn, s_gdn, b_gdn = gdn_mixer(dqkv, dz, db, da, w_gdn_conv[li], gdn_a_log[li],
                                        gdn_dt_bias[li], gdn_norm[li], st_gdn[li], cb_gdn[li], chunk)
        o_hg, s_hg = hgrn_mixer(hq, hf, hi, hg, lower_bounds[li], hgrn_norm[li], st_hg[li], chunk)
        h = h + jnp.concatenate([o_gla, o_gdn, o_hg], axis=-1) @ w_out[li]
        xn = rms_norm(h, norm_ffn[li])
        up, b_ffn = causal_dwconv(xn @ w_up[li], cb_ffn[li], w_ffn_conv[li])
        gate, val = split_cols(up, (D_FF, D_FF))
        h = h + (jax.nn.silu(gate) * val) @ w_down[li]
        ple_gate = jax.nn.sigmoid(rms_norm(h, norm_ple[li]) @ w_ple_gate[li])
        h = h + ple_gate * (pe[li].astype(h.dtype) @ w_ple_proj[li])
        n_gla.append(s_gla)
        n_gdn.append(s_gdn)
        n_gconv.append(b_gdn)
        n_hg.append(s_hg)
        n_fconv.append(b_ffn)
    y = rms_norm(h, norm_final)
    return (y, jnp.stack(n_gla), jnp.stack(n_gdn), jnp.stack(n_gconv),
            jnp.stack(n_hg), jnp.stack(n_fconv))


def setup_inputs(seed: int = 0) -> dict:
    key = jax.random.key(seed)
    keys = jax.random.split(key, 32)
    counter = [0]

    def nxt():
        k = keys[counter[0]]
        counter[0] += 1
        return k

    def nrm(shape, scale):
        return jax.random.normal(nxt(), shape, jnp.float32) * scale

    def gain(shape):
        return 1.0 + nrm(shape, 0.05)

    return {
        'x_prompt': nrm((BATCH, SEQ, D_MODEL), 1.0),
        'x_sample': nrm((DEC_BATCH, DEC_SEQ, D_MODEL), 1.0),
        'p_prompt': nrm((DEPTH, BATCH, SEQ, D_PLE), 1.0),
        'p_sample': nrm((DEPTH, DEC_BATCH, DEC_SEQ, D_PLE), 1.0),
        'state_gla': nrm((DEPTH, DEC_BATCH, GLA_H, GLA_DK, GLA_DV), 0.5),
        'state_gdn': nrm((DEPTH, DEC_BATCH, GDN_H, GDN_DK, GDN_DV), 0.1),
        'cache_gdn_conv': nrm((DEPTH, DEC_BATCH, GDN_CONV - 1, GDN_QKV), 1.0),
        'state_hgrn': nrm((DEPTH, DEC_BATCH, HG_H, HG_DK, HG_DV), 0.5),
        'cache_ffn_conv': nrm((DEPTH, DEC_BATCH, FFN_CONV - 1, 2 * D_FF), 1.0),
        'norm_mix': gain((DEPTH, D_MODEL)),
        'w_in': nrm((DEPTH, D_MODEL, N_IN), D_MODEL ** -0.5),
        'w_gla_gate': nrm((DEPTH, GLA_RANK, GLA_KW), GLA_RANK ** -0.5),
        'b_gla_gate': nrm((DEPTH, GLA_KW), 0.1),
        'gla_norm': gain((DEPTH, GLA_DV)),
        'w_gdn_conv': nrm((DEPTH, GDN_CONV, GDN_QKV), GDN_CONV ** -0.5),
        'gdn_a_log': jnp.log(jax.random.uniform(nxt(), (DEPTH, GDN_H), jnp.float32, 1.0, 16.0)),
        'gdn_dt_bias': nrm((DEPTH, GDN_H), 0.1),
        'gdn_norm': gain((DEPTH, GDN_DV)),
        'hgrn_lb': nrm((DEPTH, HG_KW), 1.0),
        'hgrn_norm': gain((DEPTH, HG_DV)),
        'w_out': nrm((DEPTH, D_MIX, D_MODEL), D_MIX ** -0.5),
        'norm_ffn': gain((DEPTH, D_MODEL)),
        'w_up': nrm((DEPTH, D_MODEL, 2 * D_FF), D_MODEL ** -0.5),
        'w_ffn_conv': nrm((DEPTH, FFN_CONV, 2 * D_FF), FFN_CONV ** -0.5),
        'w_down': nrm((DEPTH, D_FF, D_MODEL), D_FF ** -0.5),
        'norm_ple': gain((DEPTH, D_MODEL)),
        'w_ple_gate': nrm((DEPTH, D_MODEL, D_MODEL), D_MODEL ** -0.5),
        'w_ple_proj': nrm((DEPTH, D_PLE, D_MODEL), D_PLE ** -0.5),
        'norm_final': gain((D_MODEL,)),
    }


def reference(x_prompt, x_sample, p_prompt, p_sample, state_gla, state_gdn, cache_gdn_conv,
              state_hgrn, cache_ffn_conv, norm_mix, w_in, w_gla_gate, b_gla_gate, gla_norm,
              w_gdn_conv, gdn_a_log, gdn_dt_bias, gdn_norm, hgrn_lb, hgrn_norm, w_out, norm_ffn,
              w_up, w_ffn_conv, w_down, norm_ple, w_ple_gate, w_ple_proj, norm_final):
    params = (norm_mix, w_in, w_gla_gate, b_gla_gate, gla_norm, w_gdn_conv, gdn_a_log,
              gdn_dt_bias, gdn_norm, hgrn_lb, hgrn_norm, w_out, norm_ffn, w_up, w_ffn_conv,
              w_down, norm_ple, w_ple_gate, w_ple_proj, norm_final)
    f32 = jnp.float32
    bp, tp = x_prompt.shape[0], x_prompt.shape[1]
    zero_gla = jnp.zeros((DEPTH, bp, GLA_H, GLA_DK, GLA_DV), f32)
    zero_gdn = jnp.zeros((DEPTH, bp, GDN_H, GDN_DK, GDN_DV), f32)
    zero_gconv = jnp.zeros((DEPTH, bp, GDN_CONV - 1, GDN_QKV), x_prompt.dtype)
    zero_hg = jnp.zeros((DEPTH, bp, HG_H, HG_DK, HG_DV), f32)
    zero_fconv = jnp.zeros((DEPTH, bp, FFN_CONV - 1, 2 * D_FF), x_prompt.dtype)
    (y_prompt, p_state_gla, p_state_gdn, p_cache_gdn_conv, p_state_hgrn,
     p_cache_ffn_conv) = trunk(x_prompt, p_prompt, zero_gla, zero_gdn, zero_gconv, zero_hg,
                               zero_fconv, params, min(CHUNK, tp))
    (y_sample, s_state_gla, s_state_gdn, s_cache_gdn_conv, s_state_hgrn,
     s_cache_ffn_conv) = trunk(x_sample, p_sample, state_gla, state_gdn, cache_gdn_conv,
                               state_hgrn, cache_ffn_conv, params, x_sample.shape[1])
    return (y_prompt, y_sample, p_state_gla, p_state_gdn, p_cache_gdn_conv, p_state_hgrn,
            p_cache_ffn_conv, s_state_gla, s_state_gdn, s_cache_gdn_conv, s_state_hgrn,
            s_cache_ffn_conv)
```

```cpp
#ifdef CPU_EMU
#include "cpu_shim.h"
#define DEV static inline
#define DEVM inline
#define FEXP(x) expf(x)
#define FLOG(x) logf(x)
#define FRSQ(x) (1.0f / sqrtf(x))
#define WAVE_SYNC() cpu::wave_barrier()
#define SHFL_XOR(v, m) emu_shfl_xor(v, m)
#define ROW_SHR1(v) emu_row_shr1(v)
#define LAUNDER_V(x) do {} while (0)
#define LAUNDER_S(x) do {} while (0)
#define SCHED_BAR() do {} while (0)
#else
#include <hip/hip_runtime.h>
#include <cstdio>
#include <cstdint>
#define DEV __device__ __forceinline__
#define DEVM __device__ __forceinline__
#define FEXP(x) __expf(x)
#define FLOG(x) __logf(x)
#define FRSQ(x) rsqrtf(x)
#define LAS __attribute__((address_space(3)))
#define WAVE_SYNC() do { asm volatile("s_waitcnt lgkmcnt(0)" ::: "memory"); __builtin_amdgcn_wave_barrier(); } while (0)
#define SHFL_XOR(v, m) __shfl_xor(v, m)
__device__ __forceinline__ int lane_id_() { int r; asm volatile("v_mbcnt_lo_u32_b32 %0, -1, 0\n\tv_mbcnt_hi_u32_b32 %0, -1, %0" : "=v"(r)); return r; }
#define ROW_SHR1(v) __builtin_bit_cast(float, __builtin_amdgcn_update_dpp(0, __builtin_bit_cast(int, (float)(v)), 0x111, 0xf, 0xf, true))
#define LAUNDER_V(x) asm volatile("" : "+v"(x))
#define LAUNDER_S(x) asm volatile("" : "+s"(x))
#define SCHED_BAR() __builtin_amdgcn_sched_barrier(0)
#endif

typedef unsigned short bf16;
typedef short bf16x8 __attribute__((ext_vector_type(8)));
typedef float f32x4 __attribute__((ext_vector_type(4)));
typedef float f32x2 __attribute__((ext_vector_type(2)));
typedef unsigned u32x4 __attribute__((ext_vector_type(4)));
typedef unsigned u32x2 __attribute__((ext_vector_type(2)));

namespace cfg {
#ifdef SMALL_CFG
constexpr int D_MODEL = 256, BATCH = 1, SEQ = 256, DEC_BATCH = 8, DEC_SEQ = 32, GLA_H = 1, GDN_H = 2, HG_H = 1, D_FF = 256;
#else
constexpr int D_MODEL = 4096, BATCH = 4, SEQ = 2048, DEC_BATCH = 8, DEC_SEQ = 32, GLA_H = 4, GDN_H = 16, HG_H = 8, D_FF = 11008;
#endif
constexpr int DEPTH = 2, CHUNK = 64, D_PLE = 256, DK = 128, GLA_DV = 256, GDN_DV = 128, HG_DV = 128, RANK = 16, GCONV = 4, FCONV = 3;
constexpr float EPS = 1e-6f, TINY = 1e-30f;
constexpr int GLA_KW = GLA_H * DK, GLA_VW = GLA_H * GLA_DV, GDN_KW = GDN_H * DK, GDN_VW = GDN_H * GDN_DV, GDN_QKV = 2 * GDN_KW + GDN_VW;
constexpr int HG_KW = HG_H * DK, HG_VW = HG_H * HG_DV, D_MIX = GLA_VW + GDN_VW + HG_VW, NUP = 2 * D_FF;
constexpr int N_IN = 2 * GLA_KW + 2 * GLA_VW + RANK + GDN_QKV + GDN_VW + 2 * GDN_H + 2 * HG_KW + 2 * HG_VW;
constexpr int MP = BATCH * SEQ, MS = DEC_BATCH * DEC_SEQ, M = MP + MS;
constexpr int C_GQ = 0, C_GK = GLA_KW, C_GV = 2 * GLA_KW, C_GG = C_GV + GLA_VW, C_DQ = C_GG + GLA_VW, C_DK = C_DQ + GDN_KW, C_DV = C_DK + GDN_KW;
constexpr int C_DZ = C_DV + GDN_VW, C_HQ = C_DZ + GDN_VW, C_HF = C_HQ + HG_KW, C_HI = C_HF + HG_KW, C_HG = C_HI + HG_VW, NBIG = C_HG + HG_VW, N1 = NBIG + 256;
constexpr int O_DB = C_HQ + RANK;
constexpr int S_DB = RANK, S_DA = RANK + GDN_H, NSMALL = RANK + 2 * GDN_H;
static_assert(DEC_SEQ % 16 == 0 && NSMALL <= 64 && NBIG % 256 == 0 && M % 256 == 0 && D_MODEL % 256 == 0 && NUP % 256 == 0 && D_FF % 128 == 0 && D_MIX % 128 == 0, "tile shapes");
static_assert(N_IN == NBIG + NSMALL, "column bookkeeping");
constexpr int NCHP = MP / CHUNK, NCHS = DEC_BATCH, NCH = NCHP + NCHS, CPS = SEQ / CHUNK;
constexpr int NHT = GLA_H + GDN_H + HG_H, NU = NCH * NHT, NUG = NCH * GDN_H, NSEQ = BATCH + DEC_BATCH;
constexpr int NCG = 2 * GLA_H + GDN_H + HG_H;
constexpr size_t O_Y = 0, O_PGLA = (size_t)M * D_MODEL, SZ_GLA = (size_t)GLA_H * DK * GLA_DV, SZ_GDN = (size_t)GDN_H * DK * GDN_DV, SZ_HG = (size_t)HG_H * DK * HG_DV;
constexpr size_t O_PGDN = O_PGLA + DEPTH * BATCH * SZ_GLA, O_PGC = O_PGDN + DEPTH * BATCH * SZ_GDN, O_PHG = O_PGC + (size_t)DEPTH * BATCH * 3 * GDN_QKV;
constexpr size_t O_PFC = O_PHG + DEPTH * BATCH * SZ_HG, O_SGLA = O_PFC + (size_t)DEPTH * BATCH * 2 * NUP, O_SGDN = O_SGLA + DEPTH * DEC_BATCH * SZ_GLA;
constexpr size_t O_SGC = O_SGDN + DEPTH * DEC_BATCH * SZ_GDN, O_SHG = O_SGC + (size_t)DEPTH * DEC_BATCH * 3 * GDN_QKV, O_SFC = O_SHG + DEPTH * DEC_BATCH * SZ_HG;
constexpr size_t OUT_TOTAL = O_SFC + (size_t)DEPTH * DEC_BATCH * 2 * NUP;
}
using namespace cfg;

constexpr size_t al4k(size_t x) { return (x + 4095) & ~(size_t)4095; }
constexpr size_t WS_CTL = 0, CTL_ZERO_BYTES = 1u << 20;
constexpr size_t SZ_WIN = (size_t)N1 * D_MODEL * 2, SZ_WOUT = (size_t)D_MODEL * D_MIX * 2, SZ_WUP = (size_t)NUP * D_MODEL * 2, SZ_WDN = (size_t)D_MODEL * D_FF * 2;
constexpr size_t SZ_WPG = (size_t)D_MODEL * D_MODEL * 2, SZ_WPP = (size_t)D_MODEL * D_PLE * 2;
constexpr size_t WS_WIN = CTL_ZERO_BYTES, WS_WOUT = WS_WIN + DEPTH * al4k(SZ_WIN), WS_WUP = WS_WOUT + DEPTH * al4k(SZ_WOUT), WS_WDN = WS_WUP + DEPTH * al4k(SZ_WUP);
constexpr size_t WS_WPG = WS_WDN + DEPTH * al4k(SZ_WDN), WS_WPP = WS_WPG + DEPTH * al4k(SZ_WPG), WS_XN = WS_WPP + DEPTH * al4k(SZ_WPP);
constexpr size_t WS_PROJ = WS_XN + al4k((size_t)M * D_MODEL * 2), WS_PSM = WS_PROJ + al4k((size_t)M * NBIG * 2), WS_OB = WS_PSM + al4k((size_t)M * 64 * 4);
constexpr size_t WS_ORAW = WS_OB + al4k((size_t)M * D_MIX * 2), WS_H = WS_ORAW + al4k((size_t)M * D_MIX * 4), WS_UP = WS_H + al4k((size_t)M * D_MODEL * 4);
constexpr size_t WS_ACT = WS_UP + al4k((size_t)M * NUP * 2), WS_PE = WS_ACT + al4k((size_t)M * D_FF * 2), WS_PP = WS_PE + al4k((size_t)DEPTH * M * D_PLE * 2);
constexpr size_t WS_QB = WS_PP + al4k((size_t)M * D_MODEL * 4), WS_KBT = WS_QB + al4k((size_t)NU * 8192 * 2), WS_AQK = WS_KBT + al4k((size_t)NU * 8192 * 2);
constexpr size_t WS_DL = WS_AQK + al4k((size_t)NU * 4096 * 2), WS_WN = WS_DL + al4k((size_t)NU * 128 * 4), WS_U = WS_WN + al4k((size_t)NUG * 8192 * 2);
constexpr size_t WS_XB1 = WS_U + al4k((size_t)NUG * 8192 * 4), WS_SS = WS_XB1 + al4k((size_t)M * D_MODEL * 2);
constexpr size_t WS_DMYROWS = WS_SS + al4k((size_t)(3 * DEPTH + 1) * M * 8);
constexpr size_t WS_SIDE = WS_DMYROWS + al4k((size_t)64 * D_MIX * 4);
constexpr size_t WS_END = WS_SIDE + al4k((size_t)(MP / 64) * 4 * NUP * 2);
constexpr int CW_BAR = 4096;

DEV float bf2f(bf16 b) { unsigned u = ((unsigned)b) << 16; float f; __builtin_memcpy(&f, &u, 4); return f; }
#ifdef CPU_EMU
DEV unsigned f2bf(float f) { unsigned u; __builtin_memcpy(&u, &f, 4); return (u + 0x7fffu + ((u >> 16) & 1u)) >> 16; }
DEV unsigned pk2(float lo, float hi) { return f2bf(lo) | (f2bf(hi) << 16); }
#else
DEV unsigned pk2(float lo, float hi) { unsigned r; asm("v_cvt_pk_bf16_f32 %0, %1, %2" : "=v"(r) : "v"(lo), "v"(hi)); return r; }
DEV unsigned f2bf(float f) { return pk2(f, 0.f) & 0xffffu; }
#endif
DEV f32x4 unpack4(const u32x2 w) { return (f32x4){bf2f((bf16)(w.x & 0xffff)), bf2f((bf16)(w.x >> 16)), bf2f((bf16)(w.y & 0xffff)), bf2f((bf16)(w.y >> 16))}; }
#ifdef CPU_EMU
DEV float frcp_(float x) { return 1.0f / x; }
#else
DEV float frcp_(float x) { return __builtin_amdgcn_rcpf(x); }
#endif
DEV float sigmoidf_(float x) { return frcp_(1.0f + FEXP(-x)); }
DEV float siluf_(float x) { return x * sigmoidf_(x); }
DEV float softplusf_(float x) { return fmaxf(x, 0.f) + FLOG(1.0f + FEXP(-fabsf(x))); }
DEV float logsigmoidf_(float x) { return fminf(x, 0.f) - FLOG(1.0f + FEXP(-fabsf(x))); }
typedef unsigned long long ssq_t;
DEV void atomic_addf(ssq_t* p, float v) {
    const ssq_t q = (ssq_t)(v * 16777216.0f);
#ifdef CPU_EMU
    *p += q;
#else
    (void)__hip_atomic_fetch_add(p, q, __ATOMIC_RELAXED, __HIP_MEMORY_SCOPE_AGENT);
#endif
}
DEV float rstd_of(const ssq_t* ss, int row) { return FRSQ((float)ss[row] * (1.0f / 16777216.0f) * (1.0f / D_MODEL) + EPS); }
DEV float wave_sum(float v) {
#pragma unroll
    for (int o = 1; o < 64; o <<= 1) v += SHFL_XOR(v, o);
    return v;
}
DEV f32x4 mfma16(bf16x8 a, bf16x8 b, f32x4 c) {
#ifdef CPU_EMU
    return emu_mfma16(a, b, c);
#else
    return __builtin_amdgcn_mfma_f32_16x16x32_bf16(a, b, c, 0, 0, 0);
#endif
}

#ifndef CPU_EMU
namespace pg8 {
#define PG8_LAS __attribute__((address_space(3)))
typedef unsigned short bf16_t;
typedef short bf16x8 __attribute__((ext_vector_type(8)));
typedef float f32x4 __attribute__((ext_vector_type(4)));
typedef unsigned u32x4 __attribute__((ext_vector_type(4)));
constexpr int BM = 256, BK = 64, HALF = 128, HTB = HALF * BK * 2  , STAGE_BYTES = 8 * HTB, NXCD = 8, WGM = 4;

__host__ __device__ __forceinline__ int lds_byte(int r, int c) { const int st = (r >> 4) * 2 + (c >> 5), rr = r & 15, cc = c & 31, ob = rr * 64 + cc * 2; return st * 1024 + (ob ^ (((ob >> 9) & 1) << 5)); }
__host__ __device__ __forceinline__ void stage_rc(int b, int& R, int& C) { const int st = b / 1024, sb = b % 1024, swz = sb ^ (((sb >> 9) & 1) << 5); R = (st >> 1) * 16 + swz / 64; C = (st & 1) * 32 + (swz % 64) / 2; }
__host__ __device__ __forceinline__ int perm32(int rho) { const int n = rho >> 4, i = rho & 15; return 8 * (i >> 2) + 4 * n + (i & 3); }

struct Unit { int pm, pn; };
struct Gemm { const bf16_t* A; const bf16_t* Bt; int M, N, K; };

struct StaticOrder {
    int nM, nN, nwg, G, c, wv;
    __host__ __device__ void init(int M, int N, int G_, int c_) { nM = M / BM; nN = N / BM; nwg = nM * nN; G = G_; c = c_; }
    __host__ __device__ bool next(int i, Unit& u) const {
        const long L = (long)i * G + c; if (L >= nwg) return false;
        int wgid = (int)L; { const int q = nwg / NXCD, r = nwg % NXCD, xcd = wgid % NXCD, off = wgid / NXCD; wgid = (xcd < r ? xcd * (q + 1) : r * (q + 1) + (xcd - r) * q) + off; }
        const int nig = WGM * nN, gid = wgid / nig, fm = gid * WGM, gsz = (nM - fm) < WGM ? (nM - fm) : WGM;
        u.pm = fm + ((wgid % nig) % gsz); u.pn = (wgid % nig) / gsz; return true;
    }
    __device__ __forceinline__ void a_ready(const Unit&) const {}
    __device__ __forceinline__ void done(const Unit&) const {}
};
__device__ __forceinline__ unsigned cvt_pk_bf16(float lo, float hi) { unsigned r; asm volatile("v_cvt_pk_bf16_f32 %0, %1, %2" : "=v"(r) : "v"(lo), "v"(hi)); return r; }
template <class Epi, class Sched, bool ALIGN_EPI = false, bool SP2 = false>
__device__ __forceinline__ void gemm_phase(PG8_LAS unsigned char* lds, const Gemm g, const Sched& S, const Epi& E) {
    int tid_o = S.wv * 64 + lane_id_(); asm volatile("" : "+v"(tid_o));
    const int tid = tid_o, wid = __builtin_amdgcn_readfirstlane(tid >> 6), lane = tid & 63, wr = wid >> 2, wc = wid & 3, fr = lane & 15, fq = lane >> 4;
    const int K = g.K, nt = K / BK;
    unsigned voffA[2], voffB[2];
#pragma unroll
    for (int i = 0; i < 2; ++i) { int R, C; stage_rc(tid * 16 + i * 8192, R, C); const int Rb = Epi::PERM ? ((R & ~31) + perm32(R & 31)) : R;
        const int Ra = Epi::ROWPERM ? ((R & ~63) + 4 * (R & 15) + ((R >> 4) & 3)) : R;
        voffA[i] = (unsigned)(Ra * (Epi::ATILED ? BK : K) + C) * 2u; voffB[i] = (unsigned)(Rb * K + C) * 2u; }
    const size_t kstep = (size_t)(BK * 2);
    const size_t hstep = (size_t)HALF * K * 2;
    const size_t tstep = 2 * hstep;
    const size_t kstepA = Epi::ATILED ? (size_t)(BM * BK * 2) : kstep, hstepA = Epi::ATILED ? (size_t)(HALF * BK * 2) : hstep;
    const unsigned ldsw = (unsigned)wid * 1024u;
    const int aoff = lds_byte(wr * 64 + fr, fq * 8), boff = lds_byte(wc * 32 + fr, fq * 8);
#define PG8_SA(b, h) (((b) * 2 + (h)) * HTB)
#define PG8_SB(b, h) ((4 + (b) * 2 + (h)) * HTB)
#define PG8_STAGE(bufoff, gbase, voff) do { _Pragma("unroll") for (int _i = 0; _i < 2; ++_i) \
        __builtin_amdgcn_global_load_lds((const unsigned*)((const char*)(gbase) + (voff)[_i]), (PG8_LAS unsigned*)(lds + (bufoff) + ldsw + _i * 8192), 16, 0, 0); } while (0)
#define PG8_LDA(dst, b, h) do { _Pragma("unroll") for (int m = 0; m < 4; ++m) _Pragma("unroll") for (int k = 0; k < 2; ++k) dst[m][k] = *(const PG8_LAS bf16x8*)(lds + PG8_SA(b, h) + aoff + m * 2048 + k * 1024); } while (0)
#define PG8_LDB(dst, b, h) do { _Pragma("unroll") for (int n = 0; n < 2; ++n) _Pragma("unroll") for (int k = 0; k < 2; ++k) dst[n][k] = *(const PG8_LAS bf16x8*)(lds + PG8_SB(b, h) + boff + n * 2048 + k * 1024); } while (0)
#define PG8_MMA(ai, bj, At, Bt) do { __builtin_amdgcn_s_setprio(1); _Pragma("unroll") for (int m = 0; m < 4; ++m) _Pragma("unroll") for (int n = 0; n < 2; ++n) _Pragma("unroll") for (int k = 0; k < 2; ++k) \
        acc[ai][bj][m][n] = __builtin_amdgcn_mfma_f32_16x16x32_bf16(Bt[n][k], At[m][k], acc[ai][bj][m][n], 0, 0, 0); __builtin_amdgcn_s_setprio(0); } while (0)
#define PG8_WAIT_V(n) asm volatile("s_waitcnt vmcnt(" #n ")" ::: "memory")
#define PG8_WAIT_L(n) asm volatile("s_waitcnt lgkmcnt(" #n ")" ::: "memory")
#define PG8_BAR __builtin_amdgcn_s_barrier()
#define PG8_SCHED __builtin_amdgcn_sched_barrier(0)
    Unit cur, nxt; int ui = 0;
    if (!S.next(0, cur)) return;
    f32x4 acc[2][2][4][2];
#pragma unroll
    for (int a = 0; a < 2; ++a)
#pragma unroll
        for (int b = 0; b < 2; ++b)
#pragma unroll
            for (int m = 0; m < 4; ++m)
#pragma unroll
                for (int n = 0; n < 2; ++n) acc[a][b][m][n] = (f32x4){0.f, 0.f, 0.f, 0.f};
    bf16x8 At[4][2], B0[2][2], B1[2][2];
    const char* cA = (const char*)g.A + (size_t)cur.pm * tstep; const char* cB = (const char*)g.Bt + (size_t)cur.pn * tstep;
    S.a_ready(cur);
    if constexpr (SP2) {
        PG8_STAGE(PG8_SB(0, 0), cB, voffB); PG8_STAGE(PG8_SB(0, 1), cB + hstep, voffB); PG8_STAGE(PG8_SA(0, 0), cA, voffA); PG8_STAGE(PG8_SA(0, 1), cA + hstepA, voffA);
        if (wr == 1) PG8_BAR;
        PG8_WAIT_V(2); PG8_BAR;
        PG8_STAGE(PG8_SB(1, 0), cB + kstep, voffB); PG8_STAGE(PG8_SA(1, 0), cA + kstepA, voffA); PG8_STAGE(PG8_SB(1, 1), cB + hstep + kstep, voffB);
        PG8_WAIT_V(6); PG8_BAR;
    } else {
        PG8_STAGE(PG8_SB(0, 0), cB, voffB); PG8_STAGE(PG8_SA(0, 0), cA, voffA); PG8_STAGE(PG8_SB(0, 1), cB + hstep, voffB); PG8_STAGE(PG8_SA(0, 1), cA + hstepA, voffA);
        if (wr == 1) PG8_BAR;
        PG8_WAIT_V(4); PG8_BAR;
        PG8_STAGE(PG8_SB(1, 0), cB + kstep, voffB); PG8_STAGE(PG8_SA(1, 0), cA + kstepA, voffA); PG8_STAGE(PG8_SB(1, 1), cB + hstep + kstep, voffB);
        PG8_WAIT_V(6); PG8_BAR;
    }
    for (;;) {
        const bool has_next = S.next(ui + 1, nxt);
        const char* nA = has_next ? (const char*)g.A + (size_t)nxt.pm * tstep : cA; const char* nB = has_next ? (const char*)g.Bt + (size_t)nxt.pn * tstep : cB;
        for (int t = 0; t < nt; t += 2) {
            const bool last = (t == nt - 2);
            const char* a1 = cA + (size_t)(t + 1) * kstepA;
            const char* a2 = last ? nA : cA + (size_t)(t + 2) * kstepA; const char* b2 = last ? nB : cB + (size_t)(t + 2) * kstep;
            const char* a3 = a2 + kstepA; const char* b3 = b2 + kstep;
            if (last && has_next) S.a_ready(nxt);
            if constexpr (SP2) {
            PG8_LDB(B0, 0, 0); PG8_LDB(B1, 0, 1); PG8_SCHED; PG8_LDA(At, 0, 0); PG8_STAGE(PG8_SA(1, 1), a1 + hstepA, voffA);
            PG8_WAIT_V(8); PG8_WAIT_L(0); PG8_BAR; PG8_MMA(0, 0, At, B0); PG8_MMA(0, 1, At, B1); PG8_BAR; PG8_SCHED;
            PG8_LDA(At, 0, 1); PG8_STAGE(PG8_SB(0, 0), b2, voffB); PG8_STAGE(PG8_SB(0, 1), b2 + hstep, voffB); PG8_STAGE(PG8_SA(0, 0), a2, voffA);
            PG8_WAIT_V(8); PG8_WAIT_L(0); PG8_BAR; PG8_MMA(1, 0, At, B0); PG8_MMA(1, 1, At, B1); PG8_BAR; PG8_SCHED;
            PG8_LDB(B0, 1, 0); PG8_LDB(B1, 1, 1); PG8_SCHED; PG8_LDA(At, 1, 0); PG8_STAGE(PG8_SA(0, 1), a2 + hstepA, voffA);
            PG8_WAIT_V(8); PG8_WAIT_L(0); PG8_BAR; PG8_MMA(0, 0, At, B0); PG8_MMA(0, 1, At, B1); PG8_BAR; PG8_SCHED;
            PG8_LDA(At, 1, 1); PG8_STAGE(PG8_SB(1, 0), b3, voffB); PG8_STAGE(PG8_SB(1, 1), b3 + hstep, voffB); PG8_STAGE(PG8_SA(1, 0), a3, voffA);
            PG8_WAIT_V(8); PG8_WAIT_L(0); PG8_BAR; PG8_MMA(1, 0, At, B0); PG8_MMA(1, 1, At, B1); PG8_BAR; PG8_SCHED;
            } else {
            PG8_LDB(B0, 0, 0); PG8_SCHED; PG8_LDA(At, 0, 0); PG8_STAGE(PG8_SA(1, 1), a1 + hstepA, voffA);
            PG8_WAIT_L(8); PG8_BAR; PG8_WAIT_L(0); PG8_MMA(0, 0, At, B0); PG8_BAR; PG8_SCHED;
            PG8_LDB(B1, 0, 1); PG8_STAGE(PG8_SB(0, 0), b2, voffB);
            PG8_BAR; PG8_WAIT_L(0); PG8_MMA(0, 1, At, B1); PG8_BAR;
            PG8_LDA(At, 0, 1); PG8_STAGE(PG8_SA(0, 0), a2, voffA);
            PG8_BAR; PG8_WAIT_L(0); PG8_MMA(1, 0, At, B0); PG8_BAR; PG8_SCHED;
            PG8_STAGE(PG8_SB(0, 1), b2 + hstep, voffB);
            PG8_WAIT_V(6); PG8_BAR; PG8_MMA(1, 1, At, B1); PG8_BAR;
            PG8_LDB(B0, 1, 0); PG8_SCHED; PG8_LDA(At, 1, 0); PG8_STAGE(PG8_SA(0, 1), a2 + hstepA, voffA);
            PG8_WAIT_L(8); PG8_BAR; PG8_WAIT_L(0); PG8_MMA(0, 0, At, B0); PG8_BAR; PG8_SCHED;
            PG8_LDB(B1, 1, 1); PG8_STAGE(PG8_SB(1, 0), b3, voffB);
            PG8_BAR; PG8_WAIT_L(0); PG8_MMA(0, 1, At, B1); PG8_BAR;
            PG8_LDA(At, 1, 1); PG8_STAGE(PG8_SA(1, 0), a3, voffA);
            PG8_BAR; PG8_WAIT_L(0); PG8_MMA(1, 0, At, B0); PG8_BAR; PG8_SCHED;
            PG8_STAGE(PG8_SB(1, 1), b3 + hstep, voffB);
            PG8_WAIT_V(6); PG8_BAR; PG8_MMA(1, 1, At, B1); PG8_BAR;
            }
        }
        if constexpr (ALIGN_EPI) { if (wr == 0) PG8_BAR; }
        if constexpr (!Epi::AFTER_DRAIN) { E(acc, cur, wr, wc, fr, fq);
#ifdef EPI_TWICE
            if constexpr (Epi::PERM) { asm volatile("" ::: "memory"); E(acc, cur, wr, wc, fr, fq); }
#endif
            S.done(cur); }
        if (!has_next) break;
#pragma unroll
        for (int a = 0; a < 2; ++a)
#pragma unroll
            for (int b = 0; b < 2; ++b)
#pragma unroll
                for (int m = 0; m < 4; ++m)
#pragma unroll
                    for (int n = 0; n < 2; ++n) acc[a][b][m][n] = (f32x4){0.f, 0.f, 0.f, 0.f};
        cur = nxt; cA = nA; cB = nB; ++ui;
        if constexpr (ALIGN_EPI) { if (wr == 1) PG8_BAR; }
    }
    PG8_WAIT_V(0);
    if constexpr (!ALIGN_EPI) { if (wr == 0) PG8_BAR; }
    PG8_BAR;
    if constexpr (Epi::AFTER_DRAIN) { E.fused(acc, cur, wr, wc, fr, fq, lds, wid, lane); S.done(cur); }
#undef PG8_SA
#undef PG8_SB
#undef PG8_STAGE
#undef PG8_LDA
#undef PG8_LDB
#undef PG8_MMA
#undef PG8_WAIT_V
#undef PG8_WAIT_L
#undef PG8_BAR
#undef PG8_SCHED
}
}

#else
namespace pg8 {
typedef unsigned short bf16_t;
constexpr int BM = 256, BK = 64, HALF = 128, NXCD = 8, WGM = 4;
struct Unit { int pm, pn; };
struct Gemm { const bf16_t* A; const bf16_t* Bt; int M, N, K; };
struct StaticOrder {
    int nM, nN, nwg, G, c, wv;
    void init(int M, int N, int G_, int c_) { nM = M / BM; nN = N / BM; nwg = nM * nN; G = G_; c = c_; }
    bool next(int i, Unit& u) const {
        const long L = (long)i * G + c; if (L >= nwg) return false;
        int wgid = (int)L; { const int q = nwg / NXCD, r = nwg % NXCD, xcd = wgid % NXCD, off = wgid / NXCD; wgid = (xcd < r ? xcd * (q + 1) : r * (q + 1) + (xcd - r) * q) + off; }
        const int nig = WGM * nN, gid = wgid / nig, fm = gid * WGM, gsz = (nM - fm) < WGM ? (nM - fm) : WGM;
        u.pm = fm + ((wgid % nig) % gsz); u.pn = (wgid % nig) / gsz; return true;
    }
};
DEV unsigned cvt_pk_bf16(float lo, float hi) { return pk2(lo, hi); }
template <class Epi, class Sched, bool A_ = false, bool B_ = false>
static void gemm_phase(unsigned char*, const Gemm g, const Sched& S, const Epi& E) {
    const int tid = threadIdx.x, wid = tid >> 6, lane = tid & 63, wr = wid >> 2, wc = wid & 3, fr = lane & 15, fq = lane >> 4;
    Unit u;
    for (int ui = 0; S.next(ui, u); ++ui) {
        f32x4 acc[2][2][4][2];
        for (int ai = 0; ai < 2; ++ai) for (int bj = 0; bj < 2; ++bj) for (int m = 0; m < 4; ++m) for (int n = 0; n < 2; ++n) for (int j = 0; j < 4; ++j) {
            const int row = 256 * u.pm + 128 * ai + 64 * wr + (Epi::ROWPERM ? 4 * fr + m : 16 * m + fr);
            const int col = Epi::PERM ? (256 * u.pn + 128 * bj + 32 * wc + 8 * fq + 4 * n + j) : (256 * u.pn + 128 * bj + 32 * wc + 16 * n + 4 * fq + j);
            const bf16_t* a = g.A + (size_t)row * g.K; const bf16_t* b = g.Bt + (size_t)col * g.K; double s = 0;
            for (int k = 0; k < g.K; ++k) { const bf16_t av = Epi::ATILED ? g.A[(((size_t)(row >> 8) * (g.K / 64) + (k >> 6)) * 256 + (row & 255)) * 64 + (k & 63)] : a[k]; s += (double)bf2f(av) * (double)bf2f(b[k]); }
            acc[ai][bj][m][n][j] = (float)s; }
        E(acc, u, wr, wc, fr, fq);
    }
}
}
#endif
#ifndef PG8_SP2
#define PG8_SP2 true
#endif
#ifndef PG8_ALIGN
#define PG8_ALIGN true
#endif

struct Ctx {
    unsigned char* lds;
#ifndef CPU_EMU
    unsigned char* lds_raw_;
#endif
    const float* const* in;
    int wave, G, bid;
};
#define CWS ((unsigned char*)(c.in[30]))
#define COUT ((float*)(c.in[29]))
#ifdef CPU_EMU
#define CTID ((int)threadIdx.x)
#define CLANE ((int)threadIdx.x & 63)
#else
#define CTID (c.wave * 64 + lane_id_())
#define CLANE (lane_id_())
#endif
enum { I_XP = 0, I_XS, I_PP, I_PS, I_SGLA, I_SGDN, I_CGDN, I_SHG, I_CFFN, I_NMIX, I_WIN, I_WGG, I_BGG, I_GLAN, I_WGC, I_ALOG, I_DTB, I_GDNN, I_HLB, I_HGN,
       I_WOUT, I_NFFN, I_WUP, I_WFC, I_WDN, I_NPLE, I_WPG, I_WPP, I_NFIN };

DEV size_t proj_row(int row) { return ((size_t)(row >> 8) * (NBIG / 256) * 256 + (row & 255)) * 256; }
DEV size_t proj_col(int col) { return (size_t)(col >> 8) * 65536 + (col & 255); }
struct EpiProj {
    static constexpr bool PERM = true, AFTER_DRAIN = false, ROWPERM = false, ATILED = false;
    bf16* P; float* PSM; const ssq_t* ss;
    DEVM void operator()(const f32x4 (&acc)[2][2][4][2], const pg8::Unit& u, int wr, int wc, int fr, int fq) const {
        const int row0 = u.pm * 256 + wr * 64 + fr;
        if (u.pn < NBIG / 256) {
            const int col0 = u.pn * 256 + wc * 32 + 8 * fq;
#pragma unroll
            for (int ai = 0; ai < 2; ++ai)
#pragma unroll
                for (int m = 0; m < 4; ++m) { bf16* rowp = P + proj_row(row0 + ai * 128 + m * 16) + proj_col(col0); const float rs = rstd_of(ss, row0 + ai * 128 + m * 16);
#pragma unroll
                    for (int bj = 0; bj < 2; ++bj) { const f32x4 v0 = acc[ai][bj][m][0] * rs, v1 = acc[ai][bj][m][1] * rs; u32x4 w;
                        w.x = pg8::cvt_pk_bf16(v0[0], v0[1]); w.y = pg8::cvt_pk_bf16(v0[2], v0[3]); w.z = pg8::cvt_pk_bf16(v1[0], v1[1]); w.w = pg8::cvt_pk_bf16(v1[2], v1[3]);
                        *(u32x4*)(rowp + bj * 128) = w; } }
        } else if (wc < 2) {
#pragma unroll
            for (int ai = 0; ai < 2; ++ai)
#pragma unroll
                for (int m = 0; m < 4; ++m) { float* rowp = PSM + (size_t)(row0 + ai * 128 + m * 16) * 64 + wc * 32 + 8 * fq; const float rs = rstd_of(ss, row0 + ai * 128 + m * 16);
                    *(f32x4*)rowp = acc[ai][0][m][0] * rs; *(f32x4*)(rowp + 4) = acc[ai][0][m][1] * rs; }
        }
    }
};
struct EpiBf16Out {
    static constexpr bool PERM = true, AFTER_DRAIN = false, ROWPERM = false, ATILED = false;
    bf16* O; int ldc; const ssq_t* ss;
    DEVM void operator()(const f32x4 (&acc)[2][2][4][2], const pg8::Unit& u, int wr, int wc, int fr, int fq) const {
        const int row0 = u.pm * 256 + wr * 64 + fr, col0 = u.pn * 256 + wc * 32 + 8 * fq;
#pragma unroll
        for (int ai = 0; ai < 2; ++ai)
#pragma unroll
            for (int m = 0; m < 4; ++m) { bf16* rowp = O + (size_t)(row0 + ai * 128 + m * 16) * ldc + col0; const float rs = ss ? rstd_of(ss, row0 + ai * 128 + m * 16) : 1.0f;
#pragma unroll
                for (int bj = 0; bj < 2; ++bj) { const f32x4 v0 = acc[ai][bj][m][0] * rs, v1 = acc[ai][bj][m][1] * rs; u32x4 w;
                    w.x = pg8::cvt_pk_bf16(v0[0], v0[1]); w.y = pg8::cvt_pk_bf16(v0[2], v0[3]); w.z = pg8::cvt_pk_bf16(v1[0], v1[1]); w.w = pg8::cvt_pk_bf16(v1[2], v1[3]);
                    *(u32x4*)(rowp + bj * 128) = w; } }
    }
};
template <int MODE  > struct EpiF32 {
    static constexpr bool PERM = false, AFTER_DRAIN = false, ROWPERM = false, ATILED = false;
    float* C; int ldc; const float* Gm;
    bf16* XB; ssq_t* ssout; const ssq_t* ssin;
    DEVM void operator()(const f32x4 (&acc)[2][2][4][2], const pg8::Unit& u, int wr, int wc, int fr, int fq) const {
        const int row0 = u.pm * 256 + wr * 64 + fr, col0 = u.pn * 256 + wc * 32 + 4 * fq;
        float sqs[8];
#pragma unroll
        for (int ai = 0; ai < 2; ++ai)
#pragma unroll
            for (int m = 0; m < 4; ++m) { const int row = row0 + ai * 128 + m * 16; const size_t off = (size_t)row * ldc + col0; float sq = 0.f; float rs = 1.f;
                if (MODE == 2) rs = rstd_of(ssin, row);
#pragma unroll
                for (int bj = 0; bj < 2; ++bj)
#pragma unroll
                    for (int n = 0; n < 2; ++n) { const size_t o2 = off + bj * 128 + n * 16; f32x4 v = acc[ai][bj][m][n];
                        if (MODE == 1) v = v + *(const f32x4*)(C + o2);
                        if (MODE == 2) { const f32x4 g = *(const f32x4*)(Gm + o2), c0 = *(const f32x4*)(C + o2);
                            v = (f32x4){c0[0] + sigmoidf_(v[0] * rs) * g[0], c0[1] + sigmoidf_(v[1] * rs) * g[1], c0[2] + sigmoidf_(v[2] * rs) * g[2], c0[3] + sigmoidf_(v[3] * rs) * g[3]}; }
                        *(f32x4*)(C + o2) = v;
                        if (MODE != 0) { u32x2 w; w.x = pk2(v[0], v[1]); w.y = pk2(v[2], v[3]); *(u32x2*)(XB + o2) = w; sq += (v[0] * v[0] + v[1] * v[1]) + (v[2] * v[2] + v[3] * v[3]); } }
                sqs[ai * 4 + m] = sq;
#ifndef CPU_EMU
                if (MODE != 0) asm volatile("" ::: "memory");
#endif
            }
        if (MODE != 0) {
#pragma unroll
            for (int k = 0; k < 8; ++k) { float sq = sqs[k]; sq += SHFL_XOR(sq, 16); sq += SHFL_XOR(sq, 32);
                if (fq == 0) atomic_addf(ssout + row0 + (k >> 2) * 128 + (k & 3) * 16, sq); } }
    }
};

template <int MODE, bool ATILED_ = false> struct EpiRes {
    static constexpr bool PERM = true, AFTER_DRAIN = false, ROWPERM = false, ATILED = ATILED_;
    const bf16* Rin; bf16* Rout; int ldc; const bf16* Gm; ssq_t* ssout; const ssq_t* ssin;
    DEVM void operator()(const f32x4 (&acc)[2][2][4][2], const pg8::Unit& u, int wr, int wc, int fr, int fq) const {
        const int row0 = u.pm * 256 + wr * 64 + fr, col0 = u.pn * 256 + wc * 32 + 8 * fq;
        float sqs[8];
#pragma unroll
        for (int ai = 0; ai < 2; ++ai)
#pragma unroll
            for (int m = 0; m < 4; ++m) { const int row = row0 + ai * 128 + m * 16; const size_t off = (size_t)row * ldc + col0; float sq = 0.f; float rs = 1.f;
                if (MODE == 2) rs = rstd_of(ssin, row);
#pragma unroll
                for (int bj = 0; bj < 2; ++bj) { const size_t o2 = off + bj * 128; f32x4 v0 = acc[ai][bj][m][0], v1 = acc[ai][bj][m][1];
                    const u32x4 cin = *(const u32x4*)(Rin + o2); const f32x4 c0 = unpack4((u32x2){cin.x, cin.y}), c1 = unpack4((u32x2){cin.z, cin.w});
                    if (MODE == 1) { v0 = v0 + c0; v1 = v1 + c1; }
                    if (MODE == 2) { const u32x4 gin = *(const u32x4*)(Gm + o2); const f32x4 g0 = unpack4((u32x2){gin.x, gin.y}), g1 = unpack4((u32x2){gin.z, gin.w});
                        v0 = (f32x4){c0[0] + sigmoidf_(v0[0] * rs) * g0[0], c0[1] + sigmoidf_(v0[1] * rs) * g0[1], c0[2] + sigmoidf_(v0[2] * rs) * g0[2], c0[3] + sigmoidf_(v0[3] * rs) * g0[3]};
                        v1 = (f32x4){c1[0] + sigmoidf_(v1[0] * rs) * g1[0], c1[1] + sigmoidf_(v1[1] * rs) * g1[1], c1[2] + sigmoidf_(v1[2] * rs) * g1[2], c1[3] + sigmoidf_(v1[3] * rs) * g1[3]}; }
                    u32x4 w; w.x = pk2(v0[0], v0[1]); w.y = pk2(v0[2], v0[3]); w.z = pk2(v1[0], v1[1]); w.w = pk2(v1[2], v1[3]); *(u32x4*)(Rout + o2) = w;
                    const f32x4 r0 = unpack4((u32x2){w.x, w.y}), r1 = unpack4((u32x2){w.z, w.w});
                    sq += ((r0[0] * r0[0] + r0[1] * r0[1]) + (r0[2] * r0[2] + r0[3] * r0[3])) + ((r1[0] * r1[0] + r1[1] * r1[1]) + (r1[2] * r1[2] + r1[3] * r1[3])); }
                sqs[ai * 4 + m] = sq;
#ifndef CPU_EMU
                asm volatile("" ::: "memory");
#endif
            }
#pragma unroll
        for (int k = 0; k < 8; ++k) { float sq = sqs[k]; sq += SHFL_XOR(sq, 16); sq += SHFL_XOR(sq, 32);
            if (fq == 0) atomic_addf(ssout + row0 + (k >> 2) * 128 + (k & 3) * 16, sq); }
    }
};

DEV size_t act_off(int row, int col) { return (((size_t)(row >> 8) * (D_FF / 64) + (col >> 6)) * 256 + (row & 255)) * 64 + (col & 63); }
template <int L> struct EpiUpAct {
    static constexpr bool PERM = true, AFTER_DRAIN = false, ROWPERM = true, ATILED = false;
    const float* const* in;
    DEVM void operator()(const f32x4 (&acc)[2][2][4][2], const pg8::Unit& u, int wr, int wc, int fr, int fq) const {
        unsigned char* const ws = (unsigned char*)in[30]; const ssq_t* const ss = (const ssq_t*)(ws + WS_SS) + (size_t)(3 * L + 1) * M; const float* const wf = in[I_WFC] + (size_t)L * FCONV * NUP;
        const int c8 = u.pn * 128 + wc * 32 + 8 * fq;
        if (u.pm >= MP / 256) {
#pragma unroll
            for (int ai = 0; ai < 2; ++ai)
#pragma unroll
                for (int m = 0; m < 4; ++m) { const int row = u.pm * 256 + ai * 128 + wr * 64 + 4 * fr + m; const float rs = rstd_of(ss, row);
#pragma unroll
                    for (int bj = 0; bj < 2; ++bj) { const f32x4 v0 = acc[ai][bj][m][0] * rs, v1 = acc[ai][bj][m][1] * rs; u32x4 w;
                        w.x = pk2(v0[0], v0[1]); w.y = pk2(v0[2], v0[3]); w.z = pk2(v1[0], v1[1]); w.w = pk2(v1[2], v1[3]);
                        *(u32x4*)((bf16*)(ws + WS_UP) + (size_t)row * NUP + bj * D_FF + c8) = w; } }
            return;
        }
        const bool edge0 = fr == 0, edge = edge0 || fr == 15;
#pragma unroll
        for (int ai = 0; ai < 2; ++ai) {
            const int B = u.pm * 4 + ai * 2 + wr, rowb = 64 * B + 4 * fr;
            float rs[4];
#pragma unroll
            for (int m = 0; m < 4; ++m) rs[m] = rstd_of(ss, rowb + m);
            unsigned ow[4][4];
            bf16* const sp = (bf16*)(ws + WS_SIDE) + ((size_t)B * 4 + (edge0 ? 0 : 2)) * NUP + c8;
#pragma unroll
            for (int n = 0; n < 2; ++n) {
                f32x4 wg[3], wv[3];
#pragma unroll
                for (int t = 0; t < 3; ++t) { wg[t] = *(const f32x4*)(wf + (size_t)t * NUP + c8 + 4 * n); wv[t] = *(const f32x4*)(wf + (size_t)t * NUP + D_FF + c8 + 4 * n); }
                float o[4][4], rg[2][4], rv[2][4];
#pragma unroll
                for (int jp = 0; jp < 2; ++jp) {
                    f32x2 xg[4], xv[4];
#pragma unroll
                    for (int m = 0; m < 4; ++m) { xg[m] = (f32x2){acc[ai][0][m][n][2 * jp], acc[ai][0][m][n][2 * jp + 1]} * rs[m]; xv[m] = (f32x2){acc[ai][1][m][n][2 * jp], acc[ai][1][m][n][2 * jp + 1]} * rs[m]; }
                    const f32x2 pg3 = (f32x2){ROW_SHR1(xg[3][0]), ROW_SHR1(xg[3][1])}, pg2 = (f32x2){ROW_SHR1(xg[2][0]), ROW_SHR1(xg[2][1])};
                    const f32x2 pv3 = (f32x2){ROW_SHR1(xv[3][0]), ROW_SHR1(xv[3][1])}, pv2 = (f32x2){ROW_SHR1(xv[2][0]), ROW_SHR1(xv[2][1])};
                    const f32x2 w0 = (f32x2){wg[0][2 * jp], wg[0][2 * jp + 1]}, w1 = (f32x2){wg[1][2 * jp], wg[1][2 * jp + 1]}, w2 = (f32x2){wg[2][2 * jp], wg[2][2 * jp + 1]};
                    const f32x2 u0 = (f32x2){wv[0][2 * jp], wv[0][2 * jp + 1]}, u1 = (f32x2){wv[1][2 * jp], wv[1][2 * jp + 1]}, u2 = (f32x2){wv[2][2 * jp], wv[2][2 * jp + 1]};
                    f32x2 yg[4], yv[4];
                    yg[0] = w2 * xg[0] + w1 * pg3 + w0 * pg2; yg[1] = w2 * xg[1] + w1 * xg[0] + w0 * pg3; yg[2] = w2 * xg[2] + w1 * xg[1] + w0 * xg[0]; yg[3] = w2 * xg[3] + w1 * xg[2] + w0 * xg[1];
                    yv[0] = u2 * xv[0] + u1 * pv3 + u0 * pv2; yv[1] = u2 * xv[1] + u1 * xv[0] + u0 * pv3; yv[2] = u2 * xv[2] + u1 * xv[1] + u0 * xv[0]; yv[3] = u2 * xv[3] + u1 * xv[2] + u0 * xv[1];
#pragma unroll
                    for (int m = 0; m < 4; ++m) { const f32x2 sg_ = (f32x2){sigmoidf_(yg[m][0]), sigmoidf_(yg[m][1])}; const f32x2 r = yg[m] * sg_ * yv[m]; o[m][2 * jp] = r[0]; o[m][2 * jp + 1] = r[1]; }
#pragma unroll
                    for (int e = 0; e < 2; ++e) { rg[0][2 * jp + e] = edge0 ? xg[0][e] : xg[2][e]; rg[1][2 * jp + e] = edge0 ? xg[1][e] : xg[3][e]; rv[0][2 * jp + e] = edge0 ? xv[0][e] : xv[2][e]; rv[1][2 * jp + e] = edge0 ? xv[1][e] : xv[3][e]; }
                }
#pragma unroll
                for (int m = 0; m < 4; ++m) { ow[m][2 * n] = pk2(o[m][0], o[m][1]); ow[m][2 * n + 1] = pk2(o[m][2], o[m][3]); }
                if (edge) {
#pragma unroll
                    for (int q = 0; q < 2; ++q) { u32x2 a, b; a.x = pk2(rg[q][0], rg[q][1]); a.y = pk2(rg[q][2], rg[q][3]); b.x = pk2(rv[q][0], rv[q][1]); b.y = pk2(rv[q][2], rv[q][3]);
                        *(u32x2*)(sp + (size_t)q * NUP + 4 * n) = a; *(u32x2*)(sp + (size_t)q * NUP + D_FF + 4 * n) = b; } }
            }
#pragma unroll
            for (int m = 0; m < 4; ++m) { u32x4 w; w.x = ow[m][0]; w.y = ow[m][1]; w.z = ow[m][2]; w.w = ow[m][3]; *(u32x4*)((bf16*)(ws + WS_ACT) + act_off(rowb + m, c8)) = w; }
#ifndef CPU_EMU
            asm volatile("" ::: "memory");
#endif
        }
    }
};

DEV int map_in(int n) {
    if (n < C_DQ) return n;
    if (n < C_HQ) return n + RANK;
    if (n < NBIG) return n + RANK + 2 * GDN_H;
    const int s = n - NBIG;
    if (s < RANK) return C_DQ + s;
    if (s < NSMALL) return O_DB + (s - RANK);
    return -1;
}
DEV f32x4 ld_nt4(const float* p) {
#ifdef CPU_EMU
    return *(const f32x4*)p;
#else
    return __builtin_nontemporal_load((const f32x4*)p);
#endif
}
DEV int map_up(int n) { return ((n >> 7) & 1) * D_FF + 128 * (n >> 8) + (n & 127); }
DEV void transpose_item(const float* W, int K, int Nsrc, bf16* WT, int kind, const float* gain, unsigned* scr, int kb, int nb, int lane) {
    const int k0 = 64 * kb, n0 = 64 * nb, ks = lane >> 4, n4 = lane & 15; const int ncol = n0 + 4 * n4; const int sc = kind == 1 ? map_in(ncol) : kind == 2 ? map_up(ncol) : ncol;
    f32x4 v[16];
    const float* src = W + (size_t)(k0 + 2 * ks) * Nsrc + (sc >= 0 ? sc : 0);
#pragma unroll
    for (int i = 0; i < 16; ++i) v[i] = ld_nt4(src + (size_t)(8 * (i >> 1) + (i & 1)) * Nsrc);
    if (sc < 0) {
#pragma unroll
        for (int i = 0; i < 16; ++i) v[i] = (f32x4){0.f, 0.f, 0.f, 0.f}; }
    if (gain) {
#pragma unroll
        for (int i = 0; i < 16; ++i) v[i] = v[i] * gain[k0 + 2 * ks + 8 * (i >> 1) + (i & 1)]; }
#pragma unroll
    for (int m = 0; m < 8; ++m) {
#pragma unroll
        for (int e = 0; e < 4; ++e) scr[(4 * n4 + e) * 33 + 4 * m + ks] = pk2(v[2 * m][e], v[2 * m + 1][e]); }
    WAVE_SYNC();
    const int c = lane & 7;
#pragma unroll
    for (int j = 0; j < 8; ++j) { const int n = (lane >> 3) + 8 * j; const unsigned* sp = scr + n * 33 + 4 * c;
        u32x4 o; o.x = sp[0]; o.y = sp[1]; o.z = sp[2]; o.w = sp[3];
        *(u32x4*)(WT + (size_t)(n0 + n) * K + k0 + 8 * c) = o; }
    WAVE_SYNC();
}
DEV void transpose_matrix(Ctx& c, const float* W, int K, int Nsrc, int Ndst, bf16* WT, int kind, const float* gain, int gw, int NGW) {
    unsigned* scr = (unsigned*)(c.lds + c.wave * 16384);
    const int nblk = Ndst / 64, nitems = (K / 64) * nblk;
    for (int it = gw; it < nitems; it += NGW) transpose_item(W, K, Nsrc, WT, kind, gain, scr, it / nblk, it % nblk, CLANE);
}
DEV void conv_win(Ctx& c, int l, int gw, int NGW) { transpose_matrix(c, c.in[I_WIN] + (size_t)l * D_MODEL * N_IN, D_MODEL, N_IN, N1, (bf16*)(CWS + WS_WIN + l * al4k(SZ_WIN)), 1, c.in[I_NMIX] + (size_t)l * D_MODEL, gw, NGW); }
DEV void conv_wout(Ctx& c, int l, int gw, int NGW) { transpose_matrix(c, c.in[I_WOUT] + (size_t)l * D_MIX * D_MODEL, D_MIX, D_MODEL, D_MODEL, (bf16*)(CWS + WS_WOUT + l * al4k(SZ_WOUT)), 0, nullptr, gw, NGW); }
DEV void conv_wup(Ctx& c, int l, int gw, int NGW) { transpose_matrix(c, c.in[I_WUP] + (size_t)l * D_MODEL * NUP, D_MODEL, NUP, NUP, (bf16*)(CWS + WS_WUP + l * al4k(SZ_WUP)), 2, c.in[I_NFFN] + (size_t)l * D_MODEL, gw, NGW); }
DEV void conv_wdn(Ctx& c, int l, int gw, int NGW) { transpose_matrix(c, c.in[I_WDN] + (size_t)l * D_FF * D_MODEL, D_FF, D_MODEL, D_MODEL, (bf16*)(CWS + WS_WDN + l * al4k(SZ_WDN)), 0, nullptr, gw, NGW); }
DEV void conv_wpg(Ctx& c, int l, int gw, int NGW) { transpose_matrix(c, c.in[I_WPG] + (size_t)l * D_MODEL * D_MODEL, D_MODEL, D_MODEL, D_MODEL, (bf16*)(CWS + WS_WPG + l * al4k(SZ_WPG)), 0, c.in[I_NPLE] + (size_t)l * D_MODEL, gw, NGW); }
DEV void conv_wpp(Ctx& c, int l, int gw, int NGW) { transpose_matrix(c, c.in[I_WPP] + (size_t)l * D_PLE * D_MODEL, D_PLE, D_MODEL, D_MODEL, (bf16*)(CWS + WS_WPP + l * al4k(SZ_WPP)), 0, nullptr, gw, NGW); }
DEV bool conv_side(Ctx& c, int k) {
    constexpr int NB_IN = N1 / 64, N_IN_ITEMS = (D_MODEL / 64) * NB_IN, NB_PP = D_MODEL / 64, N_PP_ITEMS = (D_PLE / 64) * NB_PP;
    constexpr int TOTAL = (DEPTH - 1) * N_IN_ITEMS + DEPTH * N_PP_ITEMS;
    const int NGW = c.G * 8; const long base = (long)k * NGW; if (base >= TOTAL) return false;
    int it = (int)base + c.bid * 8 + c.wave; unsigned* scr = (unsigned*)(c.lds + c.wave * 16384);
    if (it < TOTAL) {
        if (it < (DEPTH - 1) * N_IN_ITEMS) { const int l = 1 + it / N_IN_ITEMS, r = it % N_IN_ITEMS;
            transpose_item(c.in[I_WIN] + (size_t)l * D_MODEL * N_IN, D_MODEL, N_IN, (bf16*)(CWS + WS_WIN + l * al4k(SZ_WIN)), 1, c.in[I_NMIX] + (size_t)l * D_MODEL, scr, r / NB_IN, r % NB_IN, CLANE); }
        else { it -= (DEPTH - 1) * N_IN_ITEMS; const int l = it / N_PP_ITEMS, r = it % N_PP_ITEMS;
            transpose_item(c.in[I_WPP] + (size_t)l * D_PLE * D_MODEL, D_PLE, D_MODEL, (bf16*)(CWS + WS_WPP + l * al4k(SZ_WPP)), 0, nullptr, scr, r / NB_PP, r % NB_PP, CLANE); }
    }
    return true;
}
DEV void first_row(const float* xrow, bf16* xb, ssq_t* ss, int lane) {
    constexpr int NJ = D_MODEL / 256; float s = 0.f;
#pragma unroll
    for (int j = 0; j < NJ; ++j) { const f32x4 v = *(const f32x4*)(xrow + 4 * lane + 256 * j); u32x2 w; w.x = pk2(v[0], v[1]); w.y = pk2(v[2], v[3]); *(u32x2*)(xb + 4 * lane + 256 * j) = w;
        const f32x4 t = unpack4(w); s += (t[0] * t[0] + t[1] * t[1]) + (t[2] * t[2] + t[3] * t[3]); }
    s = wave_sum(s); if (lane == 0) *ss = (ssq_t)(s * 16777216.0f);
}
DEV void final_row(const bf16* hrow, const float* gain, float rs, float* y, int lane) {
    constexpr int NJ = D_MODEL / 256;
#pragma unroll
    for (int j = 0; j < NJ; ++j) { const f32x4 v = unpack4(*(const u32x2*)(hrow + 4 * lane + 256 * j)), g = *(const f32x4*)(gain + 4 * lane + 256 * j); *(f32x4*)(y + 4 * lane + 256 * j) = v * rs * g; }
}
DEV void phase_prologue(Ctx& c) {
    { const int gw0 = c.bid * 8 + c.wave, NGW0 = c.G * 8;
      conv_win(c, 0, gw0, NGW0); }
    const int gw = c.bid * 8 + c.wave, NGW = c.G * 8;
    for (int m = gw; m < M; m += NGW) {
        const float* xr = m < MP ? c.in[I_XP] + (size_t)m * D_MODEL : c.in[I_XS] + (size_t)(m - MP) * D_MODEL;
        first_row(xr, (bf16*)(CWS + WS_XN) + (size_t)m * D_MODEL, (ssq_t*)(CWS + WS_SS) + m, CLANE);
    }
    for (int i = c.bid * 512 + CTID; i < 3 * DEPTH * M; i += c.G * 512) ((ssq_t*)(CWS + WS_SS))[M + i] = 0ull;
    bf16* PE = (bf16*)(CWS + WS_PE);
    for (size_t i = (size_t)c.bid * 512 + CTID; i < (size_t)DEPTH * M * D_PLE / 4; i += (size_t)c.G * 512) {
        const size_t e = i * 4; const int l = (int)(e / ((size_t)M * D_PLE)); const size_t r = e % ((size_t)M * D_PLE); const int m = (int)(r / D_PLE), cc = (int)(r % D_PLE);
        const float* src = m < MP ? c.in[I_PP] + ((size_t)l * MP + m) * D_PLE + cc : c.in[I_PS] + ((size_t)l * MS + (m - MP)) * D_PLE + cc;
        const f32x4 v = *(const f32x4*)src; u32x2 w; w.x = pk2(v[0], v[1]); w.y = pk2(v[2], v[3]); *(u32x2*)(PE + e) = w;
    }
}
DEV void phase_final(Ctx& c) {
    const int gw = c.bid * 8 + c.wave, NGW = c.G * 8; const ssq_t* ss = (const ssq_t*)(CWS + WS_SS) + (size_t)(3 * DEPTH) * M;
    const bf16* R = (const bf16*)(CWS + ((DEPTH & 1) ? WS_XB1 : WS_XN));
    for (int m = gw; m < M; m += NGW) final_row(R + (size_t)m * D_MODEL, c.in[I_NFIN], rstd_of(ss, m), COUT + O_Y + (size_t)m * D_MODEL, CLANE);
}

struct Chunk { int row0, nvalid, seq, cpos0; bool sample; int sb; };
DEV Chunk chunk_of(int cid) {
    Chunk k;
    if (cid < NCHP) { k.row0 = cid * CHUNK; k.nvalid = CHUNK; k.seq = cid / CPS; k.cpos0 = (cid % CPS) * CHUNK; k.sample = false; k.sb = 0; }
    else { k.sb = cid - NCHP; k.row0 = MP + DEC_SEQ * k.sb; k.nvalid = DEC_SEQ; k.seq = BATCH + k.sb; k.cpos0 = 0; k.sample = true; }
    return k;
}
DEV int rec_u(int cid, int hid) { return cid < NCHP ? ((cid / CPS) * NHT + hid) * CPS + cid % CPS : NCHP * NHT + (cid - NCHP) * NHT + hid; }
DEV int rec_ug(int cid, int hg) { return cid < NCHP ? ((cid / CPS) * GDN_H + hg) * CPS + cid % CPS : NCHP * GDN_H + (cid - NCHP) * GDN_H + hg; }
constexpr int PF = 132;
constexpr int PA = 136, PK = 72;

DEV bf16x8 ldF(const bf16* p) { bf16x8 r; const u32x4 w = *(const u32x4*)p; __builtin_memcpy(&r, &w, 16); return r; }
DEV void tri_decode(int p, int& tt, int& st) { tt = p >= 6 ? 3 : p >= 3 ? 2 : p >= 1 ? 1 : 0; st = p - tt * (tt + 1) / 2; }
DEV void up_decode(int p, int& tt, int& st) { tt = p >= 5 ? 2 : p >= 3 ? 1 : 0; st = p >= 5 ? 3 : p >= 3 ? p - 1 : p + 1; }
DEV void m1_lin(Ctx& c, int layer, int cid, int hid, bool is_gla, int h) {
    bf16* QT = (bf16*)c.lds; bf16* KT = QT + 64 * PA; bf16* AQ = KT + 160 * PA; float* lrs = (float*)(c.lds + 70144); float* part = lrs + 1024;
    int tid_ = CTID, wave_ = c.wave; LAUNDER_V(tid_); LAUNDER_S(wave_);
    const Chunk ck = chunk_of(cid); const int u = rec_u(cid, hid); const int tid = tid_, lane = tid & 63, q = lane >> 4, r = lane & 15;
    const bf16* PROJ = (const bf16*)(CWS + WS_PROJ); const float* PSM = (const float*)(CWS + WS_PSM);
    const int d = tid & 127, tq = wave_ >> 1;
    if (is_gla && tid < 256) { const int t = tid >> 2, c4 = tid & 3; f32x4 v = (f32x4){0.f, 0.f, 0.f, 0.f};
        if (t < ck.nvalid) v = *(const f32x4*)(PSM + (size_t)(ck.row0 + t) * 64 + 4 * c4);
        *(f32x4*)(lrs + t * 16 + 4 * c4) = v; }
    float bgd = 0.f, wgr[RANK], lb = 0.f;
#pragma unroll
    for (int rr = 0; rr < RANK; ++rr) wgr[rr] = 0.f;
    if (is_gla) { bgd = c.in[I_BGG][(size_t)layer * GLA_KW + h * 128 + d]; const float* wg = c.in[I_WGG] + (size_t)layer * RANK * GLA_KW + h * 128 + d;
#pragma unroll
        for (int rr = 0; rr < RANK; ++rr) wgr[rr] = wg[(size_t)rr * GLA_KW]; }
    else { float mx = -3.0e38f; for (int j = 0; j < DEPTH; ++j) mx = fmaxf(mx, c.in[I_HLB][(size_t)j * HG_KW + h * 128 + d]);
        float den = 0.f, num = 0.f; for (int j = 0; j < DEPTH; ++j) { const float e = FEXP(c.in[I_HLB][(size_t)j * HG_KW + h * 128 + d] - mx); den += e; if (j >= 1 && j <= layer) num += e; }
        lb = num / den; }
    const int c1 = (is_gla ? C_GQ : C_HQ) + h * 128 + d, c2 = (is_gla ? C_GK : C_HF) + h * 128 + d;
    bf16 r1[16], r2[16];
#pragma unroll
    for (int i = 0; i < 16; ++i) { const int t = 16 * tq + i; const int tc = t < ck.nvalid ? t : ck.nvalid - 1; const bf16* pr = PROJ + proj_row(ck.row0 + tc); r1[i] = pr[proj_col(c1)]; r2[i] = pr[proj_col(c2)]; }
    __syncthreads();
    float qv[16], kv[16], bv[16]; float run = 0.f;
#pragma unroll
    for (int i = 0; i < 16; ++i) { const int t = 16 * tq + i; float qq = 0.f, kk_ = 0.f, g = 0.f;
        if (t < ck.nvalid) {
            if (is_gla) { qq = bf2f(r1[i]) * 0.08838834764831845f; kk_ = bf2f(r2[i]); float pre = bgd;
#pragma unroll
                for (int r4 = 0; r4 < RANK / 4; ++r4) { const f32x4 l4 = *(const f32x4*)(lrs + t * 16 + 4 * r4); pre += l4[0] * wgr[4 * r4] + l4[1] * wgr[4 * r4 + 1] + l4[2] * wgr[4 * r4 + 2] + l4[3] * wgr[4 * r4 + 3]; }
                g = logsigmoidf_(pre) * (1.0f / 16.0f); }
            else { const float z = bf2f(r2[i]); const float sg = sigmoidf_(z), f = fmaxf(lb, TINY) + (1.0f - lb) * sg;
                g = FLOG(f); kk_ = (1.0f - lb) * sigmoidf_(-z); qq = siluf_(bf2f(r1[i])); }
        }
        run += g; qv[i] = qq; kv[i] = kk_; bv[i] = run;
#ifndef CPU_EMU
        if ((i & 3) == 3) asm volatile("" ::: "memory");
#endif
    }
    part[tq * 128 + d] = run;
    __syncthreads();
    float off[4]; float total = 0.f, myoff = 0.f;
#pragma unroll
    for (int j = 0; j < 4; ++j) { off[j] = total; if (j == tq) myoff = total; total += part[j * 128 + d]; }
    bf16* QB = (bf16*)(CWS + WS_QB) + (size_t)u * 8192; bf16* KBT = (bf16*)(CWS + WS_KBT) + (size_t)u * 8192; float* DL = (float*)(CWS + WS_DL) + (size_t)u * 128;
    unsigned kb[8];
#pragma unroll
    for (int i = 0; i < 16; ++i) { const int t = 16 * tq + i; const float bt = myoff + bv[i];
        QT[t * PA + d] = (bf16)f2bf(qv[i] * FEXP(bv[i]));
        QB[t * 128 + d] = (bf16)f2bf(qv[i] * FEXP(bt));
        const unsigned kbt = f2bf(kv[i] * FEXP(total - bt)); if (i & 1) kb[i >> 1] |= kbt << 16; else kb[i >> 1] = kbt;
#pragma unroll
        for (int ib = 0; ib < 4; ++ib) if (ib >= tq) KT[(8 * ib * (ib + 1) + 16 * tq + i) * PA + d] = (bf16)f2bf(kv[i] * FEXP(fminf(off[ib] - bt, 80.f)));
#ifndef CPU_EMU
        if ((i & 3) == 3) asm volatile("" ::: "memory");
#endif
    }
    { u32x4 w0, w1; w0.x = kb[0]; w0.y = kb[1]; w0.z = kb[2]; w0.w = kb[3]; w1.x = kb[4]; w1.y = kb[5]; w1.z = kb[6]; w1.w = kb[7];
      *(u32x4*)(KBT + d * 64 + 16 * tq) = w0; *(u32x4*)(KBT + d * 64 + 16 * tq + 8) = w1; }
    if (tq == 0) DL[d] = FEXP(total);
    __syncthreads();
    for (int job = wave_; job < 16; job += 8) {
        if (job < 10) { int ti, tj; tri_decode(job, ti, tj); f32x4 acc = (f32x4){0.f, 0.f, 0.f, 0.f};
#pragma unroll
            for (int kk = 0; kk < 4; ++kk) acc = mfma16(ldF(QT + (16 * ti + r) * PA + 32 * kk + 8 * q), ldF(KT + (8 * ti * (ti + 1) + 16 * tj + r) * PA + 32 * kk + 8 * q), acc);
#pragma unroll
            for (int jj = 0; jj < 4; ++jj) AQ[(16 * ti + 4 * q + jj) * PK + 16 * tj + r] = (bf16)f2bf((tj < ti || r <= 4 * q + jj) ? acc[jj] : 0.f);
        } else { int ti, tj; up_decode(job - 10, ti, tj);
#pragma unroll
            for (int jj = 0; jj < 4; ++jj) AQ[(16 * ti + 4 * q + jj) * PK + 16 * tj + r] = (bf16)0; }
    }
    __syncthreads();
    { bf16* AQK = (bf16*)(CWS + WS_AQK) + (size_t)u * 4096; *(u32x4*)(AQK + (tid >> 3) * 64 + (tid & 7) * 8) = *(const u32x4*)(AQ + (tid >> 3) * PK + (tid & 7) * 8); }
    __syncthreads();
}
DEV void split2(f32x4 x0, f32x4 x1, bf16x8& hi, bf16x8& lo) {
    unsigned h[8], l[8];
#pragma unroll
    for (int j = 0; j < 4; ++j) { h[j] = f2bf(x0[j]); l[j] = f2bf(x0[j] - bf2f((bf16)h[j])); h[4 + j] = f2bf(x1[j]); l[4 + j] = f2bf(x1[j] - bf2f((bf16)h[4 + j])); }
    u32x4 wh, wl; wh.x = h[0] | (h[1] << 16); wh.y = h[2] | (h[3] << 16); wh.z = h[4] | (h[5] << 16); wh.w = h[6] | (h[7] << 16);
    wl.x = l[0] | (l[1] << 16); wl.y = l[2] | (l[3] << 16); wl.z = l[4] | (l[5] << 16); wl.w = l[6] | (l[7] << 16);
    __builtin_memcpy(&hi, &wh, 16); __builtin_memcpy(&lo, &wl, 16);
}
DEV bf16x8 ldA(const bf16* base, int P, int row, int kk, int q);
DEV void m1_gdn(Ctx& c, int layer, int cid, int hid, int hg) {
    unsigned char* RA = c.lds; unsigned char* RB = c.lds + 59904;
    float* wts = (float*)RA; bf16* RAW = (bf16*)(RA + 6144);
    bf16* Lh = (bf16*)RA; bf16* Ll = Lh + 64 * PK; bf16* TDh = Ll + 64 * PK; bf16* TDl = TDh + 64 * PK;
    float* AD = (float*)(RA + 36864); bf16* AQ = (bf16*)(RA + 41216);
    bf16* QN = (bf16*)RB; bf16* KN = QN + 64 * PA; float* VF = (float*)(RB + 34816);
    float* betav = (float*)(RB + 68608); float* bvec = betav + 64; float* eb = bvec + 64; float* ebl = eb + 64; float* gv = ebl + 64; float* ssp = gv + 64;
    constexpr int PR = 392;
    int tid_ = CTID, wave_ = c.wave; LAUNDER_V(tid_); LAUNDER_S(wave_);
    const Chunk ck = chunk_of(cid); const int u = rec_u(cid, hid), ug = rec_ug(cid, hg); const int tid = tid_, lane = tid & 63, q = lane >> 4, r = lane & 15;
    const bf16* PROJ = (const bf16*)(CWS + WS_PROJ); const float* PSM = (const float*)(CWS + WS_PSM);
    const float* wconv = c.in[I_WGC] + (size_t)layer * GCONV * GDN_QKV; const float* cache = c.in[I_CGDN] + ((size_t)layer * DEC_BATCH + ck.sb) * 3 * GDN_QKV;
    for (int i = tid; i < GCONV * 384; i += 512) { const int j = i / 384, cc = i % 384; wts[i] = wconv[(size_t)j * GDN_QKV + (cc >> 7) * GDN_KW + hg * 128 + (cc & 127)]; }
    { u32x4 rv[7]; bool ok[7];
#pragma unroll
      for (int k = 0; k < 7; ++k) { const int i = tid + 512 * k, rr = i / 48, ch = i % 48, tl = rr - (GCONV - 1);
          ok[k] = (i < 67 * 48) && (tl < ck.nvalid) && (ck.cpos0 + tl >= 0);
          const bf16* src = PROJ + proj_col(C_DQ + (ch >> 4) * GDN_KW + hg * 128 + (ch & 15) * 8);
          rv[k] = *(const u32x4*)(ok[k] ? src + proj_row(ck.row0 + tl) : src); }
#pragma unroll
      for (int k = 0; k < 7; ++k) { const int i = tid + 512 * k, rr = i / 48, ch = i % 48;
          if (i < 67 * 48) *(u32x4*)(RAW + rr * PR + ch * 8) = ok[k] ? rv[k] : (u32x4){0u, 0u, 0u, 0u}; } }
    __syncthreads();
    if (ck.sample) {
        for (int i = tid; i < 3 * 384; i += 512) { const int rr = i / 384, cc = i % 384; RAW[rr * PR + cc] = (bf16)f2bf(cache[(size_t)rr * GDN_QKV + (cc >> 7) * GDN_KW + hg * 128 + (cc & 127)]); }
        __syncthreads(); }
    float rr_[64]; float ss = 0.f; const int part = wave_, which = part >> 1, half = part & 1, col0 = which * 128 + half * 64;
    if (part < 6) { const int t = lane;
#pragma unroll
        for (int g8 = 0; g8 < 8; ++g8) { float acc[8];
#pragma unroll
            for (int e = 0; e < 8; ++e) acc[e] = 0.f;
#pragma unroll
            for (int j = 0; j < GCONV; ++j) { const u32x4 raw = *(const u32x4*)(RAW + (t + j) * PR + col0 + 8 * g8); const f32x4 wa = *(const f32x4*)(wts + j * 384 + col0 + 8 * g8), wb = *(const f32x4*)(wts + j * 384 + col0 + 8 * g8 + 4);
                const unsigned rw[4] = {raw.x, raw.y, raw.z, raw.w};
#pragma unroll
                for (int e = 0; e < 4; ++e) { const float w_lo = e < 2 ? wa[2 * e] : wb[2 * e - 4], w_hi = e < 2 ? wa[2 * e + 1] : wb[2 * e - 3];
                    acc[2 * e] += w_lo * bf2f((bf16)(rw[e] & 0xffff)); acc[2 * e + 1] += w_hi * bf2f((bf16)(rw[e] >> 16)); } }
#pragma unroll
            for (int e = 0; e < 8; ++e) { const float v = t < ck.nvalid ? siluf_(acc[e]) : 0.f; rr_[8 * g8 + e] = v; ss += v * v; }
#ifndef CPU_EMU
            asm volatile("" ::: "memory");
#endif
        }
        if (which < 2) ssp[part * 64 + t] = ss;
        else {
#pragma unroll
            for (int g4 = 0; g4 < 16; ++g4) *(f32x4*)(VF + t * PF + half * 64 + 4 * g4) = (f32x4){rr_[4 * g4], rr_[4 * g4 + 1], rr_[4 * g4 + 2], rr_[4 * g4 + 3]}; }
    } else if (part == 6) { const int t = lane; float be = 0.f, g = 0.f;
        if (t < ck.nvalid) { const float* ps = PSM + (size_t)(ck.row0 + t) * 64; be = sigmoidf_(ps[S_DB + hg]);
            g = -FEXP(c.in[I_ALOG][layer * GDN_H + hg]) * softplusf_(ps[S_DA + hg] + c.in[I_DTB][layer * GDN_H + hg]); }
        betav[t] = be; gv[t] = g;
        WAVE_SYNC();
        float bt = 0.f, tot = 0.f;
        for (int s_ = 0; s_ < 64; ++s_) { const float gs = gv[s_]; tot += gs; if (s_ <= t) bt += gs; }
        bvec[t] = bt; eb[t] = FEXP(bt); ebl[t] = FEXP(tot - bt);
    }
    __syncthreads();
    if (part < 4) { const int t = lane; const float scl = FRSQ(ssp[(2 * which) * 64 + t] + ssp[(2 * which + 1) * 64 + t] + EPS) * (which == 0 ? 0.08838834764831845f : 1.0f);
        bf16* dst = (which ? KN : QN) + t * PA + half * 64;
#pragma unroll
        for (int g8 = 0; g8 < 8; ++g8) { u32x4 w; w.x = pk2(rr_[8 * g8] * scl, rr_[8 * g8 + 1] * scl); w.y = pk2(rr_[8 * g8 + 2] * scl, rr_[8 * g8 + 3] * scl);
            w.z = pk2(rr_[8 * g8 + 4] * scl, rr_[8 * g8 + 5] * scl); w.w = pk2(rr_[8 * g8 + 6] * scl, rr_[8 * g8 + 7] * scl); *(u32x4*)(dst + 8 * g8) = w; } }
    __syncthreads();
    for (int i = tid; i < 2 * 64 * PK / 8; i += 512) *(u32x4*)(TDh + i * 8) = (u32x4){0u, 0u, 0u, 0u};
    for (int job = wave_; job < 26; job += 8) {
        if (job < 20) { const int type = job / 10; int tt, st; tri_decode(job % 10, tt, st); f32x4 acc = (f32x4){0.f, 0.f, 0.f, 0.f}; const bf16* Am = type ? QN : KN;
#pragma unroll
            for (int kk = 0; kk < 4; ++kk) acc = mfma16(ldF(Am + (16 * tt + r) * PA + 32 * kk + 8 * q), ldF(KN + (16 * st + r) * PA + 32 * kk + 8 * q), acc);
#pragma unroll
            for (int jj = 0; jj < 4; ++jj) { const int t = 16 * tt + 4 * q + jj, s_ = 16 * st + r; const float dec = s_ <= t ? FEXP(bvec[t] - bvec[s_]) : 0.f;
                if (type == 0) { const float val = s_ < t ? betav[t] * acc[jj] * dec : 0.f; const unsigned hi = f2bf(-val), lo = f2bf(-val - bf2f((bf16)hi));
                    Lh[t * PK + s_] = (bf16)hi; Ll[t * PK + s_] = (bf16)lo; if (tt == st) AD[(tt * 16 + 4 * q + jj) * 17 + r] = val; }
                else AQ[t * PK + s_] = (bf16)f2bf(acc[jj] * dec); }
        } else { int tt, st; up_decode(job - 20, tt, st);
#pragma unroll
            for (int jj = 0; jj < 4; ++jj) AQ[(16 * tt + 4 * q + jj) * PK + 16 * st + r] = (bf16)0; }
    }
    __syncthreads();
    if (wave_ == 0) { const int blk = lane >> 4, j = lane & 15; float tv[16];
#pragma unroll
        for (int rr = 0; rr < 16; ++rr) { float acc = rr == j ? 1.f : 0.f;
#pragma unroll
            for (int s_ = 0; s_ < rr; ++s_) acc -= AD[(blk * 16 + rr) * 17 + s_] * tv[s_];
            tv[rr] = acc; const unsigned hi = f2bf(acc), lo = f2bf(acc - bf2f((bf16)hi));
            TDh[(16 * blk + rr) * PK + 16 * blk + j] = (bf16)hi; TDl[(16 * blk + rr) * PK + 16 * blk + j] = (bf16)lo; }
    } else {
        bf16* QB = (bf16*)(CWS + WS_QB) + (size_t)u * 8192; bf16* KBT = (bf16*)(CWS + WS_KBT) + (size_t)u * 8192; bf16* AQK = (bf16*)(CWS + WS_AQK) + (size_t)u * 4096; float* DL = (float*)(CWS + WS_DL) + (size_t)u * 128;
        for (int it = tid - 64; it < 2560 + 128; it += 448) {
            if (it < 1024) { const int t = it >> 4, c16 = it & 15; const u32x4 w = *(const u32x4*)(QN + t * PA + c16 * 8); const float e = eb[t]; const unsigned ww[4] = {w.x, w.y, w.z, w.w}; u32x4 o;
                o.x = pk2(bf2f((bf16)(ww[0] & 0xffff)) * e, bf2f((bf16)(ww[0] >> 16)) * e); o.y = pk2(bf2f((bf16)(ww[1] & 0xffff)) * e, bf2f((bf16)(ww[1] >> 16)) * e);
                o.z = pk2(bf2f((bf16)(ww[2] & 0xffff)) * e, bf2f((bf16)(ww[2] >> 16)) * e); o.w = pk2(bf2f((bf16)(ww[3] & 0xffff)) * e, bf2f((bf16)(ww[3] >> 16)) * e);
                *(u32x4*)(QB + t * 128 + c16 * 8) = o; }
            else if (it < 2048) { const int i2 = it - 1024, dd = i2 >> 3, s8 = i2 & 7; float kvv[8];
#pragma unroll
                for (int e = 0; e < 8; ++e) kvv[e] = bf2f(KN[(8 * s8 + e) * PA + dd]) * ebl[8 * s8 + e];
                u32x4 o; o.x = pk2(kvv[0], kvv[1]); o.y = pk2(kvv[2], kvv[3]); o.z = pk2(kvv[4], kvv[5]); o.w = pk2(kvv[6], kvv[7]); *(u32x4*)(KBT + dd * 64 + 8 * s8) = o; }
            else if (it < 2560) { const int i2 = it - 2048; *(u32x4*)(AQK + (i2 >> 3) * 64 + (i2 & 7) * 8) = *(const u32x4*)(AQ + (i2 >> 3) * PK + (i2 & 7) * 8); }
            else DL[it - 2560] = eb[63];
        }
    }
    __syncthreads();
    { const bool vpart = wave_ < 4; const int n0 = 32 * (wave_ & 3);
      f32x4 R[4][2], X[4][2];
#pragma unroll
      for (int i = 0; i < 4; ++i)
#pragma unroll
        for (int nt = 0; nt < 2; ++nt)
#pragma unroll
            for (int jj = 0; jj < 4; ++jj) { const int t = 16 * i + 4 * q + jj, cc = n0 + 16 * nt + r; R[i][nt][jj] = vpart ? betav[t] * VF[t * PF + cc] : betav[t] * eb[t] * bf2f(KN[t * PA + cc]); }
      const f32x4 Z = (f32x4){0.f, 0.f, 0.f, 0.f};
#pragma unroll
      for (int i = 0; i < 4; ++i) {
          if (i >= 1) {
#pragma unroll
              for (int kk = 0; kk < (i == 3 ? 2 : 1); ++kk) { const bf16x8 Ah = ldA(Lh, PK, 16 * i + r, kk, q), Al = ldA(Ll, PK, 16 * i + r, kk, q);
#pragma unroll
                  for (int nt = 0; nt < 2; ++nt) { bf16x8 Bh, Bl; split2(X[2 * kk][nt], (2 * kk + 1 < i) ? X[2 * kk + 1][nt] : Z, Bh, Bl);
                      R[i][nt] = mfma16(Ah, Bh, R[i][nt]); R[i][nt] = mfma16(Ah, Bl, R[i][nt]); R[i][nt] = mfma16(Al, Bh, R[i][nt]); } }
          }
          { const int kk = i >> 1; const bf16x8 Ah = ldA(TDh, PK, 16 * i + r, kk, q), Al = ldA(TDl, PK, 16 * i + r, kk, q);
#pragma unroll
            for (int nt = 0; nt < 2; ++nt) { bf16x8 Bh, Bl; split2((i & 1) ? Z : R[i][nt], (i & 1) ? R[i][nt] : Z, Bh, Bl);
                f32x4 x = mfma16(Ah, Bh, Z); x = mfma16(Ah, Bl, x); x = mfma16(Al, Bh, x); X[i][nt] = x; } }
#ifndef CPU_EMU
            asm volatile("" ::: "memory");
#endif
      }
      bf16* U = (bf16*)(CWS + WS_U) + (size_t)ug * 8192; bf16* WN = (bf16*)(CWS + WS_WN) + (size_t)ug * 8192;
#pragma unroll
      for (int i = 0; i < 4; ++i)
#pragma unroll
        for (int nt = 0; nt < 2; ++nt)
#pragma unroll
            for (int jj = 0; jj < 4; ++jj) { const int t = 16 * i + 4 * q + jj, cc = n0 + 16 * nt + r; if (vpart) U[t * 128 + cc] = (bf16)f2bf(X[i][nt][jj]); else WN[t * 128 + cc] = (bf16)f2bf(-X[i][nt][jj]); }
    }
    __syncthreads();
}
DEV void phase_m1(Ctx& c, int layer) {
    int kside = 0; bool more = layer == 0;
    for (int u = c.bid; u < NU; u += c.G) {
        const int cid = u / NHT, hid = u % NHT;
        if (hid >= GLA_H && hid < GLA_H + GDN_H) m1_gdn(c, layer, cid, hid, hid - GLA_H);
        else { const bool is_gla = hid < GLA_H; m1_lin(c, layer, cid, hid, is_gla, is_gla ? hid : hid - GLA_H - GDN_H); }
        if (more) { more = conv_side(c, kside++); __syncthreads(); }
    }
    while (more) { more = conv_side(c, kside++); }
    __syncthreads();
    const bf16* PROJ = (const bf16*)(CWS + WS_PROJ);
    for (int i = c.bid * 512 + CTID; i < NSEQ * 3 * GDN_QKV; i += c.G * 512) {
        const int col = i % GDN_QKV, j = (i / GDN_QKV) % 3, sq_ = i / (3 * GDN_QKV);
        int row; float* dst;
        if (sq_ < BATCH) { row = sq_ * SEQ + SEQ - 3 + j; dst = COUT + O_PGC + (((size_t)layer * BATCH + sq_) * 3 + j) * GDN_QKV + col; }
        else { const int sb = sq_ - BATCH; row = MP + sb * DEC_SEQ + DEC_SEQ - 3 + j; dst = COUT + O_SGC + (((size_t)layer * DEC_BATCH + sb) * 3 + j) * GDN_QKV + col; }
        *dst = bf2f(PROJ[proj_row(row) + proj_col(C_DQ + col)]);
    }
}

DEV bf16x8 ldA(const bf16* base, int P, int row, int kk, int q) {
    const bf16* p = base + row * P + 32 * kk + 4 * q;
    const u32x2 lo = *(const u32x2*)p, hi = *(const u32x2*)(p + 16);
    u32x4 w; w.x = lo.x; w.y = lo.y; w.z = hi.x; w.w = hi.y; bf16x8 r; __builtin_memcpy(&r, &w, 16); return r;
}
DEV bf16x8 mkB(f32x4 x0, f32x4 x1) {
    u32x4 w; w.x = pk2(x0[0], x0[1]); w.y = pk2(x0[2], x0[3]); w.z = pk2(x1[0], x1[1]); w.w = pk2(x1[2], x1[3]); bf16x8 r; __builtin_memcpy(&r, &w, 16); return r;
}
struct M2Pre { u32x4 qb[2], wn[2], kbt[2], aq; float dl; float uv[16]; };
DEV void m2_item(Ctx& c, const bool GDN, int layer, int seq, int hid, int ugh  , int dv, int e_base  , int vcol  , int ocol  ,
                 const float* st_in, float* st_out) {
    constexpr int BUFB = 62976;
    int tid_ = CTID, wave_ = c.wave; LAUNDER_V(tid_); LAUNDER_S(wave_);
    const int tid = tid_, lane = tid & 63, q = lane >> 4, r = lane & 15, e0 = e_base + 16 * wave_;
    const bf16* PROJ = (const bf16*)(CWS + WS_PROJ); float* ORAW = (float*)(CWS + WS_ORAW);
    f32x4 S[8];
#pragma unroll
    for (int dt = 0; dt < 8; ++dt)
#pragma unroll
        for (int i = 0; i < 4; ++i) S[dt][i] = st_in ? st_in[(size_t)(16 * dt + 4 * q + i) * dv + e0 + r] : 0.f;
    const bool sample = seq >= BATCH; const int nch = sample ? 1 : CPS; const int cid0 = sample ? NCHP + (seq - BATCH) : seq * CPS;
    M2Pre P;
#define M2_LOAD(ch) do { const int cid_ = cid0 + (ch); const int u_ = rec_u(cid_, hid), ug_ = rec_ug(cid_, ugh); \
        const bf16* QB_ = (const bf16*)(CWS + WS_QB) + (size_t)u_ * 8192; const bf16* KBT_ = (const bf16*)(CWS + WS_KBT) + (size_t)u_ * 8192; const bf16* AQK_ = (const bf16*)(CWS + WS_AQK) + (size_t)u_ * 4096; \
        _Pragma("unroll") for (int k = 0; k < 2; ++k) { const int i = tid + 512 * k; P.qb[k] = *(const u32x4*)(QB_ + (i >> 4) * 128 + (i & 15) * 8); P.kbt[k] = *(const u32x4*)(KBT_ + (i >> 3) * 64 + (i & 7) * 8); } \
        P.aq = *(const u32x4*)(AQK_ + (tid >> 3) * 64 + (tid & 7) * 8); P.dl = ((const float*)(CWS + WS_DL))[(size_t)u_ * 128 + (tid & 127)]; \
        if (GDN) { const bf16* WN_ = (const bf16*)(CWS + WS_WN) + (size_t)ug_ * 8192; const bf16* U_ = (const bf16*)(CWS + WS_U) + (size_t)ug_ * 8192; \
            _Pragma("unroll") for (int k = 0; k < 2; ++k) { const int i = tid + 512 * k; P.wn[k] = *(const u32x4*)(WN_ + (i >> 4) * 128 + (i & 15) * 8); } \
            _Pragma("unroll") for (int j = 0; j < 16; ++j) P.uv[j] = bf2f(U_[(16 * (j >> 2) + 4 * q + (j & 3)) * 128 + e0 + r]); } \
        else { const Chunk ck_ = chunk_of(cid_); \
            _Pragma("unroll") for (int j = 0; j < 16; ++j) { const int t = 16 * (j >> 2) + 4 * q + (j & 3); const int tc = t < ck_.nvalid ? t : ck_.nvalid - 1; \
                const unsigned raw = (unsigned)PROJ[proj_row(ck_.row0 + tc) + proj_col(vcol + e0 + r)]; P.uv[j] = bf2f((bf16)(t < ck_.nvalid ? raw : 0u)); } } } while (0)
    M2_LOAD(0);
    for (int ch = 0; ch < nch; ++ch) {
        const Chunk ck = chunk_of(cid0 + ch);
        unsigned char* buf = c.lds + (ch & 1) * BUFB;
        bf16* QBs = (bf16*)buf; bf16* WNs = QBs + 64 * PA; bf16* KBTs = WNs + 64 * PA; bf16* AQs = KBTs + 128 * PK; float* DLs = (float*)(AQs + 64 * PK);
#pragma unroll
        for (int k = 0; k < 2; ++k) { const int i = tid + 512 * k; *(u32x4*)(QBs + (i >> 4) * PA + (i & 15) * 8) = P.qb[k]; *(u32x4*)(KBTs + (i >> 3) * PK + (i & 7) * 8) = P.kbt[k];
            if (GDN) *(u32x4*)(WNs + (i >> 4) * PA + (i & 15) * 8) = P.wn[k]; }
        *(u32x4*)(AQs + (tid >> 3) * PK + (tid & 7) * 8) = P.aq; if (tid < 128) DLs[tid] = P.dl;
        float cur[16];
#pragma unroll
        for (int j = 0; j < 16; ++j) cur[j] = P.uv[j];
        __syncthreads();
        if (ch + 1 < nch) M2_LOAD(ch + 1);
        bf16x8 Sf[4];
#pragma unroll
        for (int kk = 0; kk < 4; ++kk) Sf[kk] = mkB(S[2 * kk], S[2 * kk + 1]);
        bf16x8 Vf[2];
        if (GDN) {
            f32x4 vn[4];
#pragma unroll
            for (int h2 = 0; h2 < 2; ++h2) { bf16x8 fw[2][4];
#pragma unroll
                for (int t2 = 0; t2 < 2; ++t2)
#pragma unroll
                    for (int kk = 0; kk < 4; ++kk) fw[t2][kk] = ldA(WNs, PA, 16 * (2 * h2 + t2) + r, kk, q);
                SCHED_BAR();
                f32x4 v0 = (f32x4){cur[8 * h2], cur[8 * h2 + 1], cur[8 * h2 + 2], cur[8 * h2 + 3]}, v1 = (f32x4){cur[8 * h2 + 4], cur[8 * h2 + 5], cur[8 * h2 + 6], cur[8 * h2 + 7]};
#pragma unroll
                for (int kk = 0; kk < 4; ++kk) { v0 = mfma16(fw[0][kk], Sf[kk], v0); v1 = mfma16(fw[1][kk], Sf[kk], v1); }
                vn[2 * h2] = v0; vn[2 * h2 + 1] = v1;
                SCHED_BAR(); }
            Vf[0] = mkB(vn[0], vn[1]); Vf[1] = mkB(vn[2], vn[3]);
        } else {
            Vf[0] = mkB((f32x4){cur[0], cur[1], cur[2], cur[3]}, (f32x4){cur[4], cur[5], cur[6], cur[7]});
            Vf[1] = mkB((f32x4){cur[8], cur[9], cur[10], cur[11]}, (f32x4){cur[12], cur[13], cur[14], cur[15]});
        }
#pragma unroll
        for (int h2 = 0; h2 < 2; ++h2) {
            bf16x8 fq[2][4], fa[2][2];
#pragma unroll
            for (int t2 = 0; t2 < 2; ++t2) {
#pragma unroll
                for (int kk = 0; kk < 4; ++kk) fq[t2][kk] = ldA(QBs, PA, 16 * (2 * h2 + t2) + r, kk, q);
#pragma unroll
                for (int k2 = 0; k2 < 2; ++k2) fa[t2][k2] = ldA(AQs, PK, 16 * (2 * h2 + t2) + r, k2, q); }
            SCHED_BAR();
            f32x4 o0 = (f32x4){0.f, 0.f, 0.f, 0.f}, o1 = o0;
#pragma unroll
            for (int kk = 0; kk < 4; ++kk) { o0 = mfma16(fq[0][kk], Sf[kk], o0); o1 = mfma16(fq[1][kk], Sf[kk], o1); }
#pragma unroll
            for (int k2 = 0; k2 < 2; ++k2) { o0 = mfma16(fa[0][k2], Vf[k2], o0); o1 = mfma16(fa[1][k2], Vf[k2], o1); }
            {
#pragma unroll
                for (int t2 = 0; t2 < 2; ++t2) { const int tt = 2 * h2 + t2; const f32x4 o = t2 ? o1 : o0;
                    float* dst = (16 * tt < ck.nvalid) ? ORAW + (size_t)(ck.row0 + 16 * tt + 4 * q) * D_MIX + ocol + e0 + r : (float*)(CWS + WS_DMYROWS) + (size_t)(16 * tt + 4 * q) * D_MIX + ocol + e0 + r;
#pragma unroll
                    for (int i = 0; i < 4; ++i) dst[(size_t)i * D_MIX] = o[i]; } }
            SCHED_BAR();
        }
#pragma unroll
        for (int h4 = 0; h4 < 2; ++h4) {
            bf16x8 fk[4][2]; f32x4 dl[4];
#pragma unroll
            for (int d4 = 0; d4 < 4; ++d4) { dl[d4] = *(const f32x4*)(DLs + 16 * (4 * h4 + d4) + 4 * q);
#pragma unroll
                for (int k2 = 0; k2 < 2; ++k2) fk[d4][k2] = ldA(KBTs, PK, 16 * (4 * h4 + d4) + r, k2, q); }
            SCHED_BAR();
#pragma unroll
            for (int d4 = 0; d4 < 4; ++d4) S[4 * h4 + d4] = S[4 * h4 + d4] * dl[d4];
#pragma unroll
            for (int k2 = 0; k2 < 2; ++k2)
#pragma unroll
                for (int d4 = 0; d4 < 4; ++d4) S[4 * h4 + d4] = mfma16(fk[d4][k2], Vf[k2], S[4 * h4 + d4]);
            SCHED_BAR();
        }
    }
#undef M2_LOAD
#pragma unroll
    for (int dt = 0; dt < 8; ++dt)
#pragma unroll
        for (int i = 0; i < 4; ++i) st_out[(size_t)(16 * dt + 4 * q + i) * dv + e0 + r] = S[dt][i];
    __syncthreads();
}
DEV void phase_m2(Ctx& c, int layer) {
    for (int it = c.bid; it < NSEQ * NCG; it += c.G) {
        const int seq = it / NCG, g = it % NCG;
        const bool sample = seq >= BATCH; const int sb = seq - BATCH;
        int hid, ugh = 0, dv, e_base = 0, vcol = 0, ocol; bool gdn = false; size_t so_p, so_s, hstride; const float* sin_base;
        if (g < 2 * GLA_H) { const int h = g >> 1; hid = h; dv = GLA_DV; e_base = (g & 1) * 128; vcol = C_GV + h * GLA_DV; ocol = h * GLA_DV;
            hstride = (size_t)DK * GLA_DV; sin_base = c.in[I_SGLA]; so_p = O_PGLA + ((size_t)layer * BATCH + seq) * GLA_H * hstride + h * hstride; so_s = O_SGLA + ((size_t)layer * DEC_BATCH + sb) * GLA_H * hstride + h * hstride;
            sin_base += ((size_t)layer * DEC_BATCH + sb) * GLA_H * hstride + h * hstride; }
        else if (g < 2 * GLA_H + GDN_H) { const int h = g - 2 * GLA_H; hid = GLA_H + h; ugh = h; gdn = true; dv = GDN_DV; ocol = GLA_VW + h * GDN_DV;
            hstride = (size_t)DK * GDN_DV; sin_base = c.in[I_SGDN]; so_p = O_PGDN + ((size_t)layer * BATCH + seq) * GDN_H * hstride + h * hstride; so_s = O_SGDN + ((size_t)layer * DEC_BATCH + sb) * GDN_H * hstride + h * hstride;
            sin_base += ((size_t)layer * DEC_BATCH + sb) * GDN_H * hstride + h * hstride; }
        else { const int h = g - 2 * GLA_H - GDN_H; hid = GLA_H + GDN_H + h; dv = HG_DV; vcol = C_HI + h * HG_DV; ocol = GLA_VW + GDN_VW + h * HG_DV;
            hstride = (size_t)DK * HG_DV; sin_base = c.in[I_SHG]; so_p = O_PHG + ((size_t)layer * BATCH + seq) * HG_H * hstride + h * hstride; so_s = O_SHG + ((size_t)layer * DEC_BATCH + sb) * HG_H * hstride + h * hstride;
            sin_base += ((size_t)layer * DEC_BATCH + sb) * HG_H * hstride + h * hstride; }
        m2_item(c, gdn, layer, seq, hid, ugh, dv, e_base, vcol, ocol, sample ? sin_base : nullptr, COUT + (sample ? so_s : so_p));
    }
    {
        constexpr int NLONG = BATCH * NCG; const int first = c.G > NLONG ? NLONG : 0;
        if (c.bid >= first) conv_wup(c, layer, (c.bid - first) * 8 + c.wave, (c.G - first) * 8);
    }
}

DEV float half_sum(float v) {
#pragma unroll
    for (int o = 1; o < 32; o <<= 1) v += SHFL_XOR(v, o);
    return v;
}
DEV void phase_m3(Ctx& c, int layer) {
    static_assert(GLA_DV == 256 && GDN_DV == 128 && HG_DV == 128 && GLA_VW % 256 == 0 && GDN_VW % 256 == 0, "256-column blocks never straddle mixers");
    constexpr int NJ = (D_MIX + 255) / 256;
    int tid_ = CTID, wave_ = c.wave; LAUNDER_V(tid_); LAUNDER_S(wave_);
    const int gw = c.bid * 8 + wave_, NGW = c.G * 8, lane = tid_ & 63;
    const bf16* PROJ = (const bf16*)(CWS + WS_PROJ); const float* ORAW = (const float*)(CWS + WS_ORAW); bf16* OB = (bf16*)(CWS + WS_OB);
    const f32x4 w_gla = *(const f32x4*)(c.in[I_GLAN] + (size_t)layer * GLA_DV + 4 * lane), w_gdn = *(const f32x4*)(c.in[I_GDNN] + (size_t)layer * GDN_DV + 4 * (lane & 31)), w_hg = *(const f32x4*)(c.in[I_HGN] + (size_t)layer * HG_DV + 4 * (lane & 31));
    for (int row = gw; row < M; row += NGW) {
        const float* orow = ORAW + (size_t)row * D_MIX; const bf16* prow = PROJ + proj_row(row); bf16* dst = OB + (size_t)row * D_MIX;
        f32x4 ov[NJ]; u32x2 gv[NJ];
#pragma unroll
        for (int j = 0; j < NJ; ++j) { const int col = 256 * j + 4 * lane; const bool in = col < D_MIX;
            const int gcol = col < GLA_VW ? C_GG + col : col < GLA_VW + GDN_VW ? C_DZ + (col - GLA_VW) : C_HG + (col - GLA_VW - GDN_VW);
            ov[j] = in ? *(const f32x4*)(orow + col) : (f32x4){0.f, 0.f, 0.f, 0.f}; gv[j] = in ? *(const u32x2*)(prow + proj_col(gcol)) : (u32x2){0u, 0u}; }
#pragma unroll
        for (int j = 0; j < NJ; ++j) { const int col = 256 * j + 4 * lane; const f32x4 v = ov[j];
            float ss = (v[0] * v[0] + v[1] * v[1]) + (v[2] * v[2] + v[3] * v[3]); float rs; f32x4 w;
            if (256 * j < GLA_VW) { ss = wave_sum(ss); rs = FRSQ(ss * (1.0f / GLA_DV) + EPS); w = w_gla; }
            else { ss = half_sum(ss); rs = FRSQ(ss * (1.0f / GDN_DV) + EPS); w = (256 * j < GLA_VW + GDN_VW) ? w_gdn : w_hg; }
            const f32x4 g = unpack4(gv[j]);
            u32x2 o; o.x = pk2(v[0] * rs * w[0] * siluf_(g[0]), v[1] * rs * w[1] * siluf_(g[1])); o.y = pk2(v[2] * rs * w[2] * siluf_(g[2]), v[3] * rs * w[3] * siluf_(g[3]));
            if (col < D_MIX) *(u32x2*)(dst + col) = o; }
    }
}

DEV void unpack8(const u32x4 a, float (&x)[8]) { const unsigned w[4] = {a.x, a.y, a.z, a.w};
#pragma unroll
    for (int e = 0; e < 4; ++e) { x[2 * e] = bf2f((bf16)(w[e] & 0xffff)); x[2 * e + 1] = bf2f((bf16)(w[e] >> 16)); } }
DEV void phase_f1(Ctx& c, int layer) {
    const bf16* UP = (const bf16*)(CWS + WS_UP); bf16* ACT = (bf16*)(CWS + WS_ACT); const bf16* SIDE = (const bf16*)(CWS + WS_SIDE);
    const float* wf = c.in[I_WFC] + (size_t)layer * FCONV * NUP;
    constexpr int CG = D_FF / 8, RB = 32, NRB = MS / RB;
    static_assert(SEQ % 64 == 0 && DEC_SEQ % RB == 0 && FCONV == 3 && MP % 256 == 0, "row blocks never straddle sequences");
    int tid_ = CTID; LAUNDER_V(tid_);
    for (size_t it = (size_t)c.bid * 512 + tid_; it < (size_t)NRB * CG; it += (size_t)c.G * 512) {
        const int c0 = (int)(it % CG) * 8, row0 = MP + (int)(it / CG) * RB;
        const int pos0 = (row0 - MP) % DEC_SEQ, sb = (row0 - MP) / DEC_SEQ;
        float wg[3][8], wv[3][8];
#pragma unroll
        for (int j = 0; j < 3; ++j) { const f32x4 a = *(const f32x4*)(wf + (size_t)j * NUP + c0), b = *(const f32x4*)(wf + (size_t)j * NUP + c0 + 4), d = *(const f32x4*)(wf + (size_t)j * NUP + D_FF + c0), e = *(const f32x4*)(wf + (size_t)j * NUP + D_FF + c0 + 4);
#pragma unroll
            for (int k = 0; k < 4; ++k) { wg[j][k] = a[k]; wg[j][4 + k] = b[k]; wv[j][k] = d[k]; wv[j][4 + k] = e[k]; } }
        float g2[8], g1[8], v2[8], v1[8];
        if (pos0 > 0) { const bf16* p2 = UP + (size_t)(row0 - 2) * NUP + c0; unpack8(*(const u32x4*)p2, g2); unpack8(*(const u32x4*)(p2 + D_FF), v2); unpack8(*(const u32x4*)(p2 + NUP), g1); unpack8(*(const u32x4*)(p2 + NUP + D_FF), v1); }
        else { const float* cr = c.in[I_CFFN] + ((size_t)layer * DEC_BATCH + sb) * (FCONV - 1) * NUP + c0;
#pragma unroll
            for (int e = 0; e < 8; ++e) { g2[e] = cr[e]; v2[e] = cr[D_FF + e]; g1[e] = cr[NUP + e]; v1[e] = cr[NUP + D_FF + e]; } }
#pragma unroll 1
        for (int i0 = 0; i0 < RB; i0 += 8) {
            u32x4 ra[8], rv[8];
#pragma unroll
            for (int i = 0; i < 8; ++i) { const bf16* pr = UP + (size_t)(row0 + i0 + i) * NUP + c0; ra[i] = *(const u32x4*)pr; rv[i] = *(const u32x4*)(pr + D_FF); }
#pragma unroll
            for (int i = 0; i < 8; ++i) { float xg[8], xv[8], o[8]; unpack8(ra[i], xg); unpack8(rv[i], xv);
#pragma unroll
                for (int e = 0; e < 8; ++e) { const float ga = wg[0][e] * g2[e] + wg[1][e] * g1[e] + wg[2][e] * xg[e], va = wv[0][e] * v2[e] + wv[1][e] * v1[e] + wv[2][e] * xv[e];
                    o[e] = siluf_(ga) * va; g2[e] = g1[e]; g1[e] = xg[e]; v2[e] = v1[e]; v1[e] = xv[e]; }
                u32x4 w; w.x = pk2(o[0], o[1]); w.y = pk2(o[2], o[3]); w.z = pk2(o[4], o[5]); w.w = pk2(o[6], o[7]);
                *(u32x4*)(ACT + (size_t)(row0 + i0 + i) * D_FF + c0) = w; }
        }
    }
    constexpr int NBLK = MP / 64, BPS = SEQ / 64;
    for (size_t it = (size_t)c.bid * 512 + tid_; it < (size_t)NBLK * CG; it += (size_t)c.G * 512) {
        const int c0 = (int)(it % CG) * 8, B = (int)(it / CG);
        if (B % BPS == 0) continue;
        float wg[3][8], wv[3][8];
#pragma unroll
        for (int j = 0; j < 3; ++j) { const f32x4 a = *(const f32x4*)(wf + (size_t)j * NUP + c0), b = *(const f32x4*)(wf + (size_t)j * NUP + c0 + 4), d = *(const f32x4*)(wf + (size_t)j * NUP + D_FF + c0), e = *(const f32x4*)(wf + (size_t)j * NUP + D_FF + c0 + 4);
#pragma unroll
            for (int k = 0; k < 4; ++k) { wg[j][k] = a[k]; wg[j][4 + k] = b[k]; wv[j][k] = d[k]; wv[j][4 + k] = e[k]; } }
        const bf16* sa = SIDE + ((size_t)(B - 1) * 4 + 2) * NUP + c0; const bf16* sb_ = SIDE + (size_t)B * 4 * NUP + c0;
        float gm2[8], gm1[8], g0[8], gp1[8], vm2[8], vm1[8], v0[8], vp1[8];
        unpack8(*(const u32x4*)sa, gm2); unpack8(*(const u32x4*)(sa + NUP), gm1); unpack8(*(const u32x4*)sb_, g0); unpack8(*(const u32x4*)(sb_ + NUP), gp1);
        unpack8(*(const u32x4*)(sa + D_FF), vm2); unpack8(*(const u32x4*)(sa + NUP + D_FF), vm1); unpack8(*(const u32x4*)(sb_ + D_FF), v0); unpack8(*(const u32x4*)(sb_ + NUP + D_FF), vp1);
        float o0[8], o1[8];
#pragma unroll
        for (int e = 0; e < 8; ++e) {
            o0[e] = siluf_(wg[0][e] * gm2[e] + wg[1][e] * gm1[e] + wg[2][e] * g0[e]) * (wv[0][e] * vm2[e] + wv[1][e] * vm1[e] + wv[2][e] * v0[e]);
            o1[e] = siluf_(wg[0][e] * gm1[e] + wg[1][e] * g0[e] + wg[2][e] * gp1[e]) * (wv[0][e] * vm1[e] + wv[1][e] * v0[e] + wv[2][e] * vp1[e]); }
        u32x4 w; w.x = pk2(o0[0], o0[1]); w.y = pk2(o0[2], o0[3]); w.z = pk2(o0[4], o0[5]); w.w = pk2(o0[6], o0[7]); *(u32x4*)(ACT + act_off(64 * B, c0)) = w;
        w.x = pk2(o1[0], o1[1]); w.y = pk2(o1[2], o1[3]); w.z = pk2(o1[4], o1[5]); w.w = pk2(o1[6], o1[7]); *(u32x4*)(ACT + act_off(64 * B + 1, c0)) = w;
    }
    for (int i = c.bid * 512 + CTID; i < NSEQ * 2 * NUP; i += c.G * 512) {
        const int col = i % NUP, j = (i / NUP) % 2, sq_ = i / (2 * NUP);
        if (sq_ < BATCH) COUT[O_PFC + (((size_t)layer * BATCH + sq_) * 2 + j) * NUP + col] = bf2f(SIDE[((size_t)(BPS * (sq_ + 1) - 1) * 4 + 2 + j) * NUP + col]);
        else { const int sb = sq_ - BATCH; COUT[O_SFC + (((size_t)layer * DEC_BATCH + sb) * 2 + j) * NUP + col] = bf2f(UP[(size_t)(MP + sb * DEC_SEQ + DEC_SEQ - 2 + j) * NUP + col]); }
    }
}

struct SkSet { u32x4 a0, a1, b0, b1; };
template <int MODE  >
DEV void skinny_phase(Ctx& c, const bf16* A, const bf16* Bt, int N, int K, const bf16* Rin, bf16* Rout, const bf16* Gm, int ldc, ssq_t* ssout, const ssq_t* ssin) {
    static_assert(MS % 64 == 0, "64-row tiles");
    int tid_ = CTID, wave_ = c.wave; LAUNDER_V(tid_); LAUNDER_S(wave_);
    const int tid = tid_, lane = tid & 63, q = lane >> 4, r = lane & 15, wr = wave_ >> 2, wc = wave_ & 3;
    bf16* As = (bf16*)c.lds; bf16* Bs = As + 2 * 64 * PA;
    const int srow = tid >> 4, sc16 = tid & 15;
    const int nit = K / 128;
    for (int item = c.bid; item < (MS / 64) * (N / 64); item += c.G) {
        const int rb = item % (MS / 64), cb = item / (MS / 64);
        const bf16* ga = A + (size_t)(rb * 64 + srow) * K + sc16 * 8; const bf16* gb = Bt + (size_t)(cb * 64 + srow) * K + sc16 * 8; const size_t r32 = (size_t)32 * K;
        f32x4 acc0 = (f32x4){0.f, 0.f, 0.f, 0.f}, acc1 = acc0;
        SkSet R0, R1, R2;
#define SK_LOAD(R, t) do { const int ko_ = (t) * 128; R.a0 = *(const u32x4*)(ga + ko_); R.a1 = *(const u32x4*)(ga + r32 + ko_); R.b0 = *(const u32x4*)(gb + ko_); R.b1 = *(const u32x4*)(gb + r32 + ko_); } while (0)
#define SK_STEP(R, t) do { if ((t) < nit) { bf16* as_ = As + ((t) & 1) * 64 * PA; bf16* bs_ = Bs + ((t) & 1) * 64 * PA; \
            *(u32x4*)(as_ + srow * PA + sc16 * 8) = R.a0; *(u32x4*)(as_ + (srow + 32) * PA + sc16 * 8) = R.a1; *(u32x4*)(bs_ + srow * PA + sc16 * 8) = R.b0; *(u32x4*)(bs_ + (srow + 32) * PA + sc16 * 8) = R.b1; \
            __syncthreads(); \
            if ((t) + 3 < nit) SK_LOAD(R, (t) + 3); \
            _Pragma("unroll") for (int kk = 0; kk < 4; ++kk) { const bf16x8 bfr = ldF(bs_ + (16 * wc + r) * PA + 32 * kk + 8 * q); \
                acc0 = mfma16(bfr, ldF(as_ + (32 * wr + r) * PA + 32 * kk + 8 * q), acc0); acc1 = mfma16(bfr, ldF(as_ + (32 * wr + 16 + r) * PA + 32 * kk + 8 * q), acc1); } } } while (0)
        SK_LOAD(R0, 0); if (1 < nit) SK_LOAD(R1, 1); if (2 < nit) SK_LOAD(R2, 2);
#pragma unroll 1
        for (int t = 0; t < nit; t += 3) { SK_STEP(R0, t); SK_STEP(R1, t + 1); SK_STEP(R2, t + 2); }
#undef SK_LOAD
#undef SK_STEP
#pragma unroll
        for (int mt = 0; mt < 2; ++mt) { const f32x4 v = mt ? acc1 : acc0; const int row = MP + rb * 64 + 32 * wr + 16 * mt + r; const size_t off = (size_t)row * ldc + cb * 64 + 16 * wc + 4 * q;
            f32x4 o = unpack4(*(const u32x2*)(Rin + off));
            if (MODE == 1) o = o + v;
            if (MODE == 2) { const f32x4 g = unpack4(*(const u32x2*)(Gm + off)); const float rs = rstd_of(ssin, row);
                o = (f32x4){o[0] + sigmoidf_(v[0] * rs) * g[0], o[1] + sigmoidf_(v[1] * rs) * g[1], o[2] + sigmoidf_(v[2] * rs) * g[2], o[3] + sigmoidf_(v[3] * rs) * g[3]}; }
            { u32x2 w; w.x = pk2(o[0], o[1]); w.y = pk2(o[2], o[3]); *(u32x2*)(Rout + off) = w; const f32x4 vr = unpack4(w); float sq = (vr[0] * vr[0] + vr[1] * vr[1]) + (vr[2] * vr[2] + vr[3] * vr[3]);
              sq += SHFL_XOR(sq, 16); sq += SHFL_XOR(sq, 32); if (q == 0) atomic_addf(ssout + row, sq); } }
        __syncthreads();
    }
}

#ifndef SKIP_MIN_G
#define SKIP_MIN_G 64
#endif
constexpr int PPL = 9, NPHASE = 2 + PPL * DEPTH;
#ifndef REP_PRO
#define REP_PRO 1
#endif
#ifndef REP_GEMM
#define REP_GEMM 1
#endif
#ifndef REP_MIX
#define REP_MIX 1
#endif
#ifndef REP_MISC
#define REP_MISC 1
#endif
#ifndef REP_SK
#define REP_SK REP_GEMM
#endif
#ifndef REP_M1
#define REP_M1 REP_MIX
#endif
#ifndef REP_M2
#define REP_M2 REP_MIX
#endif
#ifndef REP_M3
#define REP_M3 REP_MIX
#endif
#ifndef CPU_EMU
#define XB_TMO      128
#define XB_XCNT(j)  (256  + 64 * (j))
#define XB_XSUB(j)  (1280 + 64 * (j))
#define XB_XGEN(j)  (2304 + 64 * (j))
#define XB_TOP      3328
#define XB_TOPGEN   3392
#define XCD_BAR_WORDS 3456
#define XB_SPIN_CAP (1u << 18)

__device__ __forceinline__ unsigned xb_ld(unsigned* p)              { return __hip_atomic_load(p, __ATOMIC_RELAXED, __HIP_MEMORY_SCOPE_AGENT); }
__device__ __forceinline__ unsigned xb_add(unsigned* p, unsigned v) { return __hip_atomic_fetch_add(p, v, __ATOMIC_RELAXED, __HIP_MEMORY_SCOPE_AGENT); }
__device__ __forceinline__ unsigned xb_xcc_id() { return (unsigned)__builtin_amdgcn_s_getreg((3 << 11) | 20) & 0xFu; }
#define XB_SPIN(cond, bar) do { unsigned _sp = 0; while (cond) { __builtin_amdgcn_s_sleep(1); \
    if ((++_sp & 255u) == 0u) { if (xb_ld(&(bar)[XB_TMO])) break; if (_sp > XB_SPIN_CAP) { atomicAdd(&(bar)[XB_TMO], 1u); break; } } } } while (0)

struct XcdBarrier {
    unsigned* bar; unsigned x;
    volatile LAS unsigned* st;
    bool t0;
};

__device__ __forceinline__ XcdBarrier xcd_barrier_post(unsigned* bar, volatile LAS unsigned* st) {
    XcdBarrier b; b.bar = bar; b.x = xb_xcc_id(); b.st = st; b.t0 = threadIdx.x == 0;
    if (b.t0) (void)xb_add(&bar[XB_XCNT(b.x)], 1u);
    return b;
}
__device__ __forceinline__ void xcd_barrier_complete(unsigned* bar, unsigned x, unsigned& nloc, unsigned& nx) {
    const unsigned G = gridDim.x * gridDim.y * gridDim.z;
    unsigned sum, cnt, mine, sp = 0u;
    for (;;) {
        sum = 0u; cnt = 0u; mine = 0u;
#pragma unroll
        for (unsigned j = 0; j < 16; ++j) { const unsigned c = xb_ld(&bar[XB_XCNT(j)]); sum += c; cnt += (c > 0u) ? 1u : 0u; mine = (j == x) ? c : mine; }
        if (sum == G) break;
        __builtin_amdgcn_s_sleep(1);
        if ((++sp & 255u) == 0u) { if (xb_ld(&bar[XB_TMO])) break; if (sp > XB_SPIN_CAP) { atomicAdd(&bar[XB_TMO], 1u); break; } }
    }
    nloc = mine > 0u ? mine : 1u; nx = cnt > 0u ? cnt : 1u;
}

__device__ __forceinline__ void xcd_barrier(const XcdBarrier& b) {
    asm volatile("s_waitcnt vmcnt(0)" ::: "memory");
    __syncthreads();
    if (b.t0) {
        unsigned* bar = b.bar;
        __builtin_amdgcn_s_waitcnt(0);
        unsigned nloc = b.st[0], nx = b.st[1];
        if (nloc == 0u) { xcd_barrier_complete(bar, b.x, nloc, nx); b.st[0] = nloc; b.st[1] = nx; }
        const unsigned old = xb_add(&bar[XB_XSUB(b.x)], 1u);
        const unsigned gen = old / nloc;
        if (old + 1u == (gen + 1u) * nloc) {
            __builtin_amdgcn_fence(__ATOMIC_RELEASE, "agent");
            asm volatile("s_waitcnt vmcnt(0)" ::: "memory");
            const unsigned og = xb_add(&bar[XB_TOP], 1u);
            const unsigned tg = og / nx;
            if (og + 1u == (tg + 1u) * nx) xb_add(&bar[XB_TOPGEN], 1u);
            else XB_SPIN(xb_ld(&bar[XB_TOPGEN]) == tg, bar);
            __builtin_amdgcn_fence(__ATOMIC_ACQUIRE, "agent");
            xb_add(&bar[XB_XGEN(b.x)], 1u);
            asm volatile("s_waitcnt vmcnt(0)" ::: "memory");
        } else {
            XB_SPIN(xb_ld(&bar[XB_XGEN(b.x)]) == gen, bar);
            __builtin_amdgcn_fence(__ATOMIC_ACQUIRE, "agent");
            asm volatile("s_waitcnt vmcnt(0)" ::: "memory");
        }
    }
    __syncthreads();
}

#define GRID_BAR() do { XcdBarrier bar_; bar_.bar = (unsigned*)(CWS + WS_CTL) + CW_BAR; bar_.x = xb_xcc_id(); bar_.t0 = c.wave == 0 && lane_id_() == 0; bar_.st = (volatile LAS unsigned*)((LAS unsigned char*)c.lds_raw_ + (163840 - 256)) + 8; xcd_barrier(bar_); } while (0)
#else
#define GRID_BAR() do {} while (0)
#endif

struct Args { const float* in[29]; float* out; unsigned char* ws; int ph_lo, ph_hi; };
static_assert(sizeof(void*) == 8 && __builtin_offsetof(Args, out) == 29 * 8 && __builtin_offsetof(Args, ws) == 30 * 8, "CWS / COUT read Args through the in[] table");
#ifndef CPU_EMU
#define BAR_PARAM
#define BAR_ARG
#define LDSP ((PG8_LAS unsigned char*)c.lds_raw_)
#else
#define BAR_PARAM
#define BAR_ARG
#define LDSP (c.lds)
#endif
#define IN(k) (lo <= (k) && (k) < hi)
#ifndef REP_BAR
#define REP_BAR 1
#endif
#define SEAM(k) do { if (IN(k) && IN((k) + 1)) { GRID_BAR(); if (REP_BAR > 1) GRID_BAR(); } } while (0)
template <int l>
DEV void layer_program(Ctx& c, const int lo, const int hi BAR_PARAM) {
        constexpr int pb = 1 + PPL * l;
        ssq_t* const SS = (ssq_t*)(CWS + WS_SS);
        bf16* const Ra = (bf16*)(CWS + ((l & 1) ? WS_XB1 : WS_XN)); bf16* const Rb = (bf16*)(CWS + ((l & 1) ? WS_XN : WS_XB1));
        if (IN(pb + 0)) {
            pg8::Gemm g{Ra, (const bf16*)(CWS + WS_WIN + l * al4k(SZ_WIN)), M, N1, D_MODEL}; pg8::StaticOrder S; S.init(M, N1, c.G, c.bid); S.wv = c.wave;
            EpiProj E{(bf16*)(CWS + WS_PROJ), (float*)(CWS + WS_PSM), SS + (size_t)(3 * l) * M};
            for (int rep = 0; rep < REP_GEMM; ++rep) pg8::gemm_phase<EpiProj, pg8::StaticOrder, PG8_ALIGN, PG8_SP2>(LDSP, g, S, E);
            {
                const int nwg = (M / 256) * (N1 / 256), rem = nwg % c.G;
                if (c.bid >= rem) { conv_wout(c, l, (c.bid - rem) * 8 + c.wave, (c.G - rem) * 8); conv_wpg(c, l, (c.bid - rem) * 8 + c.wave, (c.G - rem) * 8); }
            }
        }
        SEAM(pb + 0);
        if (IN(pb + 1)) { phase_m1(c, l); if (REP_M1 > 1) phase_m1(c, l); }
        SEAM(pb + 1);
        if (IN(pb + 2)) { phase_m2(c, l); if (REP_M2 > 1) phase_m2(c, l); }
        SEAM(pb + 2);
        if (IN(pb + 3)) { phase_m3(c, l); if (REP_M3 > 1) phase_m3(c, l); }
        SEAM(pb + 3);
        if (IN(pb + 4)) {
            pg8::Gemm g{(const bf16*)(CWS + WS_OB), (const bf16*)(CWS + WS_WOUT + l * al4k(SZ_WOUT)), MP, D_MODEL, D_MIX}; pg8::StaticOrder S; S.init(MP, D_MODEL, c.G, c.bid); S.wv = c.wave;
            EpiRes<1> E{Ra, Ra, D_MODEL, nullptr, SS + (size_t)(3 * l + 1) * M, nullptr};
            pg8::gemm_phase<EpiRes<1>, pg8::StaticOrder, PG8_ALIGN, PG8_SP2>(LDSP, g, S, E);
            skinny_phase<1>(c, (const bf16*)(CWS + WS_OB) + (size_t)MP * D_MIX, (const bf16*)(CWS + WS_WOUT + l * al4k(SZ_WOUT)), D_MODEL, D_MIX, Ra, Ra, nullptr, D_MODEL, SS + (size_t)(3 * l + 1) * M, nullptr);
        }
        SEAM(pb + 4);
        if (IN(pb + 5)) {
            { pg8::Gemm g{Ra, (const bf16*)(CWS + WS_WUP + l * al4k(SZ_WUP)), M, NUP, D_MODEL}; pg8::StaticOrder S; S.init(M, NUP, c.G, c.bid); S.wv = c.wave;
              EpiUpAct<l> E{c.in};
              for (int rep = 0; rep < REP_GEMM; ++rep) pg8::gemm_phase<EpiUpAct<l>, pg8::StaticOrder, PG8_ALIGN, PG8_SP2>(LDSP, g, S, E); }
            {
              const int rem3 = ((M / 256) * (NUP / 256)) % c.G, skip = (rem3 && c.G - ((rem3 + 7) & ~7) >= SKIP_MIN_G) ? ((rem3 + 7) & ~7) : 0;
              if (c.bid >= skip) {
              pg8::Gemm g{(const bf16*)(CWS + WS_PE) + (size_t)l * M * D_PLE, (const bf16*)(CWS + WS_WPP + l * al4k(SZ_WPP)), M, D_MODEL, D_PLE}; pg8::StaticOrder S; S.init(M, D_MODEL, c.G - skip, c.bid - skip); S.wv = c.wave;
              EpiBf16Out E{(bf16*)(CWS + WS_PP), D_MODEL, nullptr};
              for (int rep = 0; rep < REP_GEMM; ++rep) pg8::gemm_phase<EpiBf16Out, pg8::StaticOrder, PG8_ALIGN, PG8_SP2>(LDSP, g, S, E); } }
            {
                const int nwg = (M / 256) * (NUP / 256), rem = nwg % c.G, first = rem ? rem : 0;
                if (c.bid >= first) { const int gw_ = (c.bid - first) * 8 + c.wave, ngw_ = (c.G - first) * 8; conv_wdn(c, l, gw_, ngw_); }
            }
        }
        SEAM(pb + 5);
        if (IN(pb + 6)) for (int rep = 0; rep < REP_MISC; ++rep) phase_f1(c, l);
        SEAM(pb + 6);
        if (IN(pb + 7)) {
            pg8::Gemm g{(const bf16*)(CWS + WS_ACT), (const bf16*)(CWS + WS_WDN + l * al4k(SZ_WDN)), MP, D_MODEL, D_FF}; pg8::StaticOrder S; S.init(MP, D_MODEL, c.G, c.bid); S.wv = c.wave;
            EpiRes<1, true> E{Ra, Ra, D_MODEL, nullptr, SS + (size_t)(3 * l + 2) * M, nullptr};
            pg8::gemm_phase<EpiRes<1, true>, pg8::StaticOrder, PG8_ALIGN, PG8_SP2>(LDSP, g, S, E);
            skinny_phase<1>(c, (const bf16*)(CWS + WS_ACT) + (size_t)MP * D_FF, (const bf16*)(CWS + WS_WDN + l * al4k(SZ_WDN)), D_MODEL, D_FF, Ra, Ra, nullptr, D_MODEL, SS + (size_t)(3 * l + 2) * M, nullptr);
        }
        SEAM(pb + 7);
        if (IN(pb + 8)) {
            pg8::Gemm g{Ra, (const bf16*)(CWS + WS_WPG + l * al4k(SZ_WPG)), MP, D_MODEL, D_MODEL}; pg8::StaticOrder S; S.init(MP, D_MODEL, c.G, c.bid); S.wv = c.wave;
            EpiRes<2> E{Ra, Rb, D_MODEL, (const bf16*)(CWS + WS_PP), SS + (size_t)(3 * l + 3) * M, SS + (size_t)(3 * l + 2) * M};
            pg8::gemm_phase<EpiRes<2>, pg8::StaticOrder, PG8_ALIGN, PG8_SP2>(LDSP, g, S, E);
            skinny_phase<2>(c, Ra + (size_t)MP * D_MODEL, (const bf16*)(CWS + WS_WPG + l * al4k(SZ_WPG)), D_MODEL, D_MODEL, Ra, Rb, (const bf16*)(CWS + WS_PP), D_MODEL, SS + (size_t)(3 * l + 3) * M, SS + (size_t)(3 * l + 2) * M);
        }
        SEAM(pb + 8);
}

#ifdef CPU_EMU
static void fwd_body(const Args& args)
#else
__global__ void __launch_bounds__(512, 2) fwd(Args args)
#endif
{
    Ctx c;
#ifdef CPU_EMU
    c.lds = cpu::g_lds;
    c.wave = (int)threadIdx.x >> 6;
#else
    extern __shared__ __attribute__((aligned(16))) unsigned char lds_raw[];
    c.lds = lds_raw; c.lds_raw_ = lds_raw;
    c.wave = __builtin_amdgcn_readfirstlane((int)threadIdx.x >> 6);
#endif
    c.G = gridDim.x; c.bid = blockIdx.x;
    c.in = args.in;
#ifndef CPU_EMU
    volatile LAS unsigned* MISC = (volatile LAS unsigned*)((LAS unsigned char*)lds_raw + (163840 - 256));
    if (CTID < 32) MISC[CTID] = 0u;
    __syncthreads();
    (void)xcd_barrier_post((unsigned*)(args.ws + WS_CTL) + CW_BAR, MISC + 8);
#endif
    const int lo = args.ph_lo, hi = args.ph_hi;
    static_assert(DEPTH == 2, "layer_program is instantiated twice");
    if (IN(0)) for (int rep = 0; rep < REP_PRO; ++rep) phase_prologue(c);
    SEAM(0);
    layer_program<0>(c, lo, hi BAR_ARG);
    layer_program<1>(c, lo, hi BAR_ARG);
    if (IN(1 + PPL * DEPTH)) phase_final(c);
}

#ifndef CPU_EMU
#ifndef MK_PER_PHASE
#define MK_PER_PHASE 0
#endif
constexpr int LDS_BYTES = 163840;
extern "C" void kernel_launch(void* const* d_in, const int* in_sizes, int n_in, void* d_out, int out_size, void* d_ws, size_t ws_size, hipStream_t stream) {
    static int grid = 0;
    if (grid == 0) {
        if (n_in != 29 || (size_t)out_size != OUT_TOTAL || ws_size < WS_END) { fprintf(stderr, "kernel_launch: unexpected shapes: n_in %d out %d (want %zu) ws %zu (want %zu)\n", n_in, out_size, (size_t)OUT_TOTAL, ws_size, (size_t)WS_END); grid = -1; return; }
        int dev = 0, cus = 0, per_cu = 0;
        if (hipGetDevice(&dev) != hipSuccess || hipDeviceGetAttribute(&cus, hipDeviceAttributeMultiprocessorCount, dev) != hipSuccess) { grid = -1; return; }
        if (hipFuncSetAttribute((const void*)fwd, hipFuncAttributeMaxDynamicSharedMemorySize, LDS_BYTES) != hipSuccess) { fprintf(stderr, "kernel_launch: hipFuncSetAttribute failed\n"); grid = -1; return; }
        if (hipOccupancyMaxActiveBlocksPerMultiprocessor(&per_cu, (const void*)fwd, 512, LDS_BYTES) != hipSuccess || per_cu < 1) fprintf(stderr, "kernel_launch: occupancy query says %d\n", per_cu);
        (void)hipGetLastError();
        grid = cus;
    }
    if (grid < 0) return;
    if (hipMemsetAsync((char*)d_ws + WS_CTL, 0, CTL_ZERO_BYTES, stream) != hipSuccess) return;
    Args a{};
    for (int i = 0; i < 29; ++i) a.in[i] = (const float*)d_in[i];
    a.out = (float*)d_out; a.ws = (unsigned char*)d_ws;
#if MK_PER_PHASE
    for (int p = 0; p < NPHASE; ++p) { a.ph_lo = p; a.ph_hi = p + 1; hipLaunchKernelGGL(fwd, dim3(grid), dim3(512), LDS_BYTES, stream, a); }
#else
    a.ph_lo = 0; a.ph_hi = NPHASE; hipLaunchKernelGGL(fwd, dim3(grid), dim3(512), LDS_BYTES, stream, a);
#endif
}
#endif
```

```cpp
#ifdef CPU_EMU
#include "cpu_shim.h"
#define DEV static inline
#define DEVM inline
#define FEXP(x) expf(x)
#define FLOG(x) logf(x)
#define FRSQ(x) (1.0f / sqrtf(x))
#define WAVE_SYNC() cpu::wave_barrier()
#define SHFL_XOR(v, m) emu_shfl_xor(v, m)
#define ROW_SHR1(v) emu_row_shr1(v)
#define LAUNDER_V(x) do {} while (0)
#define LAUNDER_S(x) do {} while (0)
#define SCHED_BAR() do {} while (0)
#else
#include <hip/hip_runtime.h>
#include <cstdio>
#include <cstdint>
#define DEV __device__ __forceinline__
#define DEVM __device__ __forceinline__
#define FEXP(x) __expf(x)
#define FLOG(x) __logf(x)
#define FRSQ(x) rsqrtf(x)
#define LAS __attribute__((address_space(3)))
#define WAVE_SYNC() do { asm volatile("s_waitcnt lgkmcnt(0)" ::: "memory"); __builtin_amdgcn_wave_barrier(); } while (0)
#define SHFL_XOR(v, m) __shfl_xor(v, m)
__device__ __forceinline__ int lane_id_() { int r; asm volatile("v_mbcnt_lo_u32_b32 %0, -1, 0\n\tv_mbcnt_hi_u32_b32 %0, -1, %0" : "=v"(r)); return r; }
#define ROW_SHR1(v) __builtin_bit_cast(float, __builtin_amdgcn_update_dpp(0, __builtin_bit_cast(int, (float)(v)), 0x111, 0xf, 0xf, true))
#define LAUNDER_V(x) asm volatile("" : "+v"(x))
#define LAUNDER_S(x) asm volatile("" : "+s"(x))
#define SCHED_BAR() __builtin_amdgcn_sched_barrier(0)
#endif

typedef unsigned short bf16;
typedef short bf16x8 __attribute__((ext_vector_type(8)));
typedef float f32x4 __attribute__((ext_vector_type(4)));
typedef float f32x2 __attribute__((ext_vector_type(2)));
typedef unsigned u32x4 __attribute__((ext_vector_type(4)));
typedef unsigned u32x2 __attribute__((ext_vector_type(2)));

namespace cfg {
#ifdef SMALL_CFG
constexpr int D_MODEL = 256, BATCH = 1, SEQ = 256, DEC_BATCH = 8, DEC_SEQ = 32, GLA_H = 1, GDN_H = 2, HG_H = 1, D_FF = 256;
#else
constexpr int D_MODEL = 4096, BATCH = 4, SEQ = 2048, DEC_BATCH = 8, DEC_SEQ = 32, GLA_H = 4, GDN_H = 16, HG_H = 8, D_FF = 11008;
#endif
constexpr int DEPTH = 2, CHUNK = 64, D_PLE = 256, DK = 128, GLA_DV = 256, GDN_DV = 128, HG_DV = 128, RANK = 16, GCONV = 4, FCONV = 3;
constexpr float EPS = 1e-6f, TINY = 1e-30f;
constexpr int GLA_KW = GLA_H * DK, GLA_VW = GLA_H * GLA_DV, GDN_KW = GDN_H * DK, GDN_VW = GDN_H * GDN_DV, GDN_QKV = 2 * GDN_KW + GDN_VW;
constexpr int HG_KW = HG_H * DK, HG_VW = HG_H * HG_DV, D_MIX = GLA_VW + GDN_VW + HG_VW, NUP = 2 * D_FF;
constexpr int N_IN = 2 * GLA_KW + 2 * GLA_VW + RANK + GDN_QKV + GDN_VW + 2 * GDN_H + 2 * HG_KW + 2 * HG_VW;
constexpr int MP = BATCH * SEQ, MS = DEC_BATCH * DEC_SEQ, M = MP + MS;
constexpr int C_GQ = 0, C_GK = GLA_KW, C_GV = 2 * GLA_KW, C_GG = C_GV + GLA_VW, C_DQ = C_GG + GLA_VW, C_DK = C_DQ + GDN_KW, C_DV = C_DK + GDN_KW;
constexpr int C_DZ = C_DV + GDN_VW, C_HQ = C_DZ + GDN_VW, C_HF = C_HQ + HG_KW, C_HI = C_HF + HG_KW, C_HG = C_HI + HG_VW, NBIG = C_HG + HG_VW, N1 = NBIG + 256;
constexpr int O_DB = C_HQ + RANK;
constexpr int S_DB = RANK, S_DA = RANK + GDN_H, NSMALL = RANK + 2 * GDN_H;
static_assert(DEC_SEQ % 16 == 0 && NSMALL <= 64 && NBIG % 256 == 0 && M % 256 == 0 && D_MODEL % 256 == 0 && NUP % 256 == 0 && D_FF % 128 == 0 && D_MIX % 128 == 0, "tile shapes");
static_assert(N_IN == NBIG + NSMALL, "column bookkeeping");
constexpr int NCHP = MP / CHUNK, NCHS = DEC_BATCH, NCH = NCHP + NCHS, CPS = SEQ / CHUNK;
constexpr int NHT = GLA_H + GDN_H + HG_H, NU = NCH * NHT, NUG = NCH * GDN_H, NSEQ = BATCH + DEC_BATCH;
constexpr int NCG = 2 * GLA_H + GDN_H + HG_H;
constexpr size_t O_Y = 0, O_PGLA = (size_t)M * D_MODEL, SZ_GLA = (size_t)GLA_H * DK * GLA_DV, SZ_GDN = (size_t)GDN_H * DK * GDN_DV, SZ_HG = (size_t)HG_H * DK * HG_DV;
constexpr size_t O_PGDN = O_PGLA + DEPTH * BATCH * SZ_GLA, O_PGC = O_PGDN + DEPTH * BATCH * SZ_GDN, O_PHG = O_PGC + (size_t)DEPTH * BATCH * 3 * GDN_QKV;
constexpr size_t O_PFC = O_PHG + DEPTH * BATCH * SZ_HG, O_SGLA = O_PFC + (size_t)DEPTH * BATCH * 2 * NUP, O_SGDN = O_SGLA + DEPTH * DEC_BATCH * SZ_GLA;
constexpr size_t O_SGC = O_SGDN + DEPTH * DEC_BATCH * SZ_GDN, O_SHG = O_SGC + (size_t)DEPTH * DEC_BATCH * 3 * GDN_QKV, O_SFC = O_SHG + DEPTH * DEC_BATCH * SZ_HG;
constexpr size_t OUT_TOTAL = O_SFC + (size_t)DEPTH * DEC_BATCH * 2 * NUP;
}
using namespace cfg;

constexpr size_t al4k(size_t x) { return (x + 4095) & ~(size_t)4095; }
constexpr size_t WS_CTL = 0, CTL_ZERO_BYTES = 1u << 20;
constexpr size_t SZ_WIN = (size_t)N1 * D_MODEL * 2, SZ_WOUT = (size_t)D_MODEL * D_MIX * 2, SZ_WUP = (size_t)NUP * D_MODEL * 2, SZ_WDN = (size_t)D_MODEL * D_FF * 2;
constexpr size_t SZ_WPG = (size_t)D_MODEL * D_MODEL * 2, SZ_WPP = (size_t)D_MODEL * D_PLE * 2;
constexpr size_t WS_WIN = CTL_ZERO_BYTES, WS_WOUT = WS_WIN + DEPTH * al4k(SZ_WIN), WS_WUP = WS_WOUT + DEPTH * al4k(SZ_WOUT), WS_WDN = WS_WUP + DEPTH * al4k(SZ_WUP);
constexpr size_t WS_WPG = WS_WDN + DEPTH * al4k(SZ_WDN), WS_WPP = WS_WPG + DEPTH * al4k(SZ_WPG), WS_XN = WS_WPP + DEPTH * al4k(SZ_WPP);
constexpr size_t WS_PROJ = WS_XN + al4k((size_t)M * D_MODEL * 2), WS_PSM = WS_PROJ + al4k((size_t)M * NBIG * 2), WS_OB = WS_PSM + al4k((size_t)M * 64 * 4);
constexpr size_t WS_ORAW = WS_OB + al4k((size_t)M * D_MIX * 2), WS_H = WS_ORAW + al4k((size_t)M * D_MIX * 4), WS_UP = WS_H + al4k((size_t)M * D_MODEL * 4);
constexpr size_t WS_ACT = WS_UP + al4k((size_t)M * NUP * 2), WS_PE = WS_ACT + al4k((size_t)M * D_FF * 2), WS_PP = WS_PE + al4k((size_t)DEPTH * M * D_PLE * 2);
constexpr size_t WS_QB = WS_PP + al4k((size_t)M * D_MODEL * 4), WS_KBT = WS_QB + al4k((size_t)NU * 8192 * 2), WS_AQK = WS_KBT + al4k((size_t)NU * 8192 * 2);
constexpr size_t WS_DL = WS_AQK + al4k((size_t)NU * 4096 * 2), WS_WN = WS_DL + al4k((size_t)NU * 128 * 4), WS_U = WS_WN + al4k((size_t)NUG * 8192 * 2);
constexpr size_t WS_XB1 = WS_U + al4k((size_t)NUG * 8192 * 4), WS_SS = WS_XB1 + al4k((size_t)M * D_MODEL * 2);
constexpr size_t WS_DMYROWS = WS_SS + al4k((size_t)(3 * DEPTH + 1) * M * 8);
constexpr size_t WS_SIDE = WS_DMYROWS + al4k((size_t)64 * D_MIX * 4);
constexpr size_t WS_END = WS_SIDE + al4k((size_t)(MP / 64) * 4 * NUP * 2);
constexpr int CW_BAR = 4096;

DEV float bf2f(bf16 b) { unsigned u = ((unsigned)b) << 16; float f; __builtin_memcpy(&f, &u, 4); return f; }
#ifdef CPU_EMU
DEV unsigned f2bf(float f) { unsigned u; __builtin_memcpy(&u, &f, 4); return (u + 0x7fffu + ((u >> 16) & 1u)) >> 16; }
DEV unsigned pk2(float lo, float hi) { return f2bf(lo) | (f2bf(hi) << 16); }
#else
DEV unsigned pk2(float lo, float hi) { unsigned r; asm("v_cvt_pk_bf16_f32 %0, %1, %2" : "=v"(r) : "v"(lo), "v"(hi)); return r; }
DEV unsigned f2bf(float f) { return pk2(f, 0.f) & 0xffffu; }
#endif
DEV f32x4 unpack4(const u32x2 w) { return (f32x4){bf2f((bf16)(w.x & 0xffff)), bf2f((bf16)(w.x >> 16)), bf2f((bf16)(w.y & 0xffff)), bf2f((bf16)(w.y >> 16))}; }
#ifdef CPU_EMU
DEV float frcp_(float x) { return 1.0f / x; }
#else
DEV float frcp_(float x) { return __builtin_amdgcn_rcpf(x); }
#endif
DEV float sigmoidf_(float x) { return frcp_(1.0f + FEXP(-x)); }
DEV float siluf_(float x) { return x * sigmoidf_(x); }
DEV float softplusf_(float x) { return fmaxf(x, 0.f) + FLOG(1.0f + FEXP(-fabsf(x))); }
DEV float logsigmoidf_(float x) { return fminf(x, 0.f) - FLOG(1.0f + FEXP(-fabsf(x))); }
typedef unsigned long long ssq_t;
DEV void atomic_addf(ssq_t* p, float v) {
    const ssq_t q = (ssq_t)(v * 16777216.0f);
#ifdef CPU_EMU
    *p += q;
#else
    (void)__hip_atomic_fetch_add(p, q, __ATOMIC_RELAXED, __HIP_MEMORY_SCOPE_AGENT);
#endif
}
DEV float rstd_of(const ssq_t* ss, int row) { return FRSQ((float)ss[row] * (1.0f / 16777216.0f) * (1.0f / D_MODEL) + EPS); }
DEV float wave_sum(float v) {
#pragma unroll
    for (int o = 1; o < 64; o <<= 1) v += SHFL_XOR(v, o);
    return v;
}
DEV f32x4 mfma16(bf16x8 a, bf16x8 b, f32x4 c) {
#ifdef CPU_EMU
    return emu_mfma16(a, b, c);
#else
    return __builtin_amdgcn_mfma_f32_16x16x32_bf16(a, b, c, 0, 0, 0);
#endif
}

#ifndef CPU_EMU
namespace pg8 {
#define PG8_LAS __attribute__((address_space(3)))
typedef unsigned short bf16_t;
typedef short bf16x8 __attribute__((ext_vector_type(8)));
typedef float f32x4 __attribute__((ext_vector_type(4)));
typedef unsigned u32x4 __attribute__((ext_vector_type(4)));
constexpr int BM = 256, BK = 64, HALF = 128, HTB = HALF * BK * 2  , STAGE_BYTES = 8 * HTB, NXCD = 8, WGM = 4;

__host__ __device__ __forceinline__ int lds_byte(int r, int c) { const int st = (r >> 4) * 2 + (c >> 5), rr = r & 15, cc = c & 31, ob = rr * 64 + cc * 2; return st * 1024 + (ob ^ (((ob >> 9) & 1) << 5)); }
__host__ __device__ __forceinline__ void stage_rc(int b, int& R, int& C) { const int st = b / 1024, sb = b % 1024, swz = sb ^ (((sb >> 9) & 1) << 5); R = (st >> 1) * 16 + swz / 64; C = (st & 1) * 32 + (swz % 64) / 2; }
__host__ __device__ __forceinline__ int perm32(int rho) { const int n = rho >> 4, i = rho & 15; return 8 * (i >> 2) + 4 * n + (i & 3); }

struct Unit { int pm, pn; };
struct Gemm { const bf16_t* A; const bf16_t* Bt; int M, N, K; };

struct StaticOrder {
    int nM, nN, nwg, G, c, wv;
    __host__ __device__ void init(int M, int N, int G_, int c_) { nM = M / BM; nN = N / BM; nwg = nM * nN; G = G_; c = c_; }
    __host__ __device__ bool next(int i, Unit& u) const {
        const long L = (long)i * G + c; if (L >= nwg) return false;
        int wgid = (int)L; { const int q = nwg / NXCD, r = nwg % NXCD, xcd = wgid % NXCD, off = wgid / NXCD; wgid = (xcd < r ? xcd * (q + 1) : r * (q + 1) + (xcd - r) * q) + off; }
        const int nig = WGM * nN, gid = wgid / nig, fm = gid * WGM, gsz = (nM - fm) < WGM ? (nM - fm) : WGM;
        u.pm = fm + ((wgid % nig) % gsz); u.pn = (wgid % nig) / gsz; return true;
    }
    __device__ __forceinline__ void a_ready(const Unit&) const {}
    __device__ __forceinline__ void done(const Unit&) const {}
};
__device__ __forceinline__ unsigned cvt_pk_bf16(float lo, float hi) { unsigned r; asm volatile("v_cvt_pk_bf16_f32 %0, %1, %2" : "=v"(r) : "v"(lo), "v"(hi)); return r; }
template <class Epi, class Sched, bool ALIGN_EPI = false, bool SP2 = false>
__device__ __forceinline__ void gemm_phase(PG8_LAS unsigned char* lds, const Gemm g, const Sched& S, const Epi& E) {
    int tid_o = S.wv * 64 + lane_id_(); asm volatile("" : "+v"(tid_o));
    const int tid = tid_o, wid = __builtin_amdgcn_readfirstlane(tid >> 6), lane = tid & 63, wr = wid >> 2, wc = wid & 3, fr = lane & 15, fq = lane >> 4;
    const int K = g.K, nt = K / BK;
    unsigned voffA[2], voffB[2];
#pragma unroll
    for (int i = 0; i < 2; ++i) { int R, C; stage_rc(tid * 16 + i * 8192, R, C); const int Rb = Epi::PERM ? ((R & ~31) + perm32(R & 31)) : R;
        const int Ra = Epi::ROWPERM ? ((R & ~63) + 4 * (R & 15) + ((R >> 4) & 3)) : R;
        voffA[i] = (unsigned)(Ra * (Epi::ATILED ? BK : K) + C) * 2u; voffB[i] = (unsigned)(Rb * K + C) * 2u; }
    const size_t kstep = (size_t)(BK * 2);
    const size_t hstep = (size_t)HALF * K * 2;
    const size_t tstep = 2 * hstep;
    const size_t kstepA = Epi::ATILED ? (size_t)(BM * BK * 2) : kstep, hstepA = Epi::ATILED ? (size_t)(HALF * BK * 2) : hstep;
    const unsigned ldsw = (unsigned)wid * 1024u;
    const int aoff = lds_byte(wr * 64 + fr, fq * 8), boff = lds_byte(wc * 32 + fr, fq * 8);
#define PG8_SA(b, h) (((b) * 2 + (h)) * HTB)
#define PG8_SB(b, h) ((4 + (b) * 2 + (h)) * HTB)
#define PG8_STAGE(bufoff, gbase, voff) do { _Pragma("unroll") for (int _i = 0; _i < 2; ++_i) \
        __builtin_amdgcn_global_load_lds((const unsigned*)((const char*)(gbase) + (voff)[_i]), (PG8_LAS unsigned*)(lds + (bufoff) + ldsw + _i * 8192), 16, 0, 0); } while (0)
#define PG8_LDA(dst, b, h) do { _Pragma("unroll") for (int m = 0; m < 4; ++m) _Pragma("unroll") for (int k = 0; k < 2; ++k) dst[m][k] = *(const PG8_LAS bf16x8*)(lds + PG8_SA(b, h) + aoff + m * 2048 + k * 1024); } while (0)
#define PG8_LDB(dst, b, h) do { _Pragma("unroll") for (int n = 0; n < 2; ++n) _Pragma("unroll") for (int k = 0; k < 2; ++k) dst[n][k] = *(const PG8_LAS bf16x8*)(lds + PG8_SB(b, h) + boff + n * 2048 + k * 1024); } while (0)
#define PG8_MMA(ai, bj, At, Bt) do { __builtin_amdgcn_s_setprio(1); _Pragma("unroll") for (int m = 0; m < 4; ++m) _Pragma("unroll") for (int n = 0; n < 2; ++n) _Pragma("unroll") for (int k = 0; k < 2; ++k) \
        acc[ai][bj][m][n] = __builtin_amdgcn_mfma_f32_16x16x32_bf16(Bt[n][k], At[m][k], acc[ai][bj][m][n], 0, 0, 0); __builtin_amdgcn_s_setprio(0); } while (0)
#define PG8_WAIT_V(n) asm volatile("s_waitcnt vmcnt(" #n ")" ::: "memory")
#define PG8_WAIT_L(n) asm volatile("s_waitcnt lgkmcnt(" #n ")" ::: "memory")
#define PG8_BAR __builtin_amdgcn_s_barrier()
#define PG8_SCHED __builtin_amdgcn_sched_barrier(0)
    Unit cur, nxt; int ui = 0;
    if (!S.next(0, cur)) return;
    f32x4 acc[2][2][4][2];
#pragma unroll
    for (int a = 0; a < 2; ++a)
#pragma unroll
        for (int b = 0; b < 2; ++b)
#pragma unroll
            for (int m = 0; m < 4; ++m)
#pragma unroll
                for (int n = 0; n < 2; ++n) acc[a][b][m][n] = (f32x4){0.f, 0.f, 0.f, 0.f};
    bf16x8 At[4][2], B0[2][2], B1[2][2];
    const char* cA = (const char*)g.A + (size_t)cur.pm * tstep; const char* cB = (const char*)g.Bt + (size_t)cur.pn * tstep;
    S.a_ready(cur);
    if constexpr (SP2) {
        PG8_STAGE(PG8_SB(0, 0), cB, voffB); PG8_STAGE(PG8_SB(0, 1), cB + hstep, voffB); PG8_STAGE(PG8_SA(0, 0), cA, voffA); PG8_STAGE(PG8_SA(0, 1), cA + hstepA, voffA);
        if (wr == 1) PG8_BAR;
        PG8_WAIT_V(2); PG8_BAR;
        PG8_STAGE(PG8_SB(1, 0), cB + kstep, voffB); PG8_STAGE(PG8_SA(1, 0), cA + kstepA, voffA); PG8_STAGE(PG8_SB(1, 1), cB + hstep + kstep, voffB);
        PG8_WAIT_V(6); PG8_BAR;
    } else {
        PG8_STAGE(PG8_SB(0, 0), cB, voffB); PG8_STAGE(PG8_SA(0, 0), cA, voffA); PG8_STAGE(PG8_SB(0, 1), cB + hstep, voffB); PG8_STAGE(PG8_SA(0, 1), cA + hstepA, voffA);
        if (wr == 1) PG8_BAR;
        PG8_WAIT_V(4); PG8_BAR;
        PG8_STAGE(PG8_SB(1, 0), cB + kstep, voffB); PG8_STAGE(PG8_SA(1, 0), cA + kstepA, voffA); PG8_STAGE(PG8_SB(1, 1), cB + hstep + kstep, voffB);
        PG8_WAIT_V(6); PG8_BAR;
    }
    for (;;) {
        const bool has_next = S.next(ui + 1, nxt);
        const char* nA = has_next ? (const char*)g.A + (size_t)nxt.pm * tstep : cA; const char* nB = has_next ? (const char*)g.Bt + (size_t)nxt.pn * tstep : cB;
        for (int t = 0; t < nt; t += 2) {
            const bool last = (t == nt - 2);
            const char* a1 = cA + (size_t)(t + 1) * kstepA;
            const char* a2 = last ? nA : cA + (size_t)(t + 2) * kstepA; const char* b2 = last ? nB : cB + (size_t)(t + 2) * kstep;
            const char* a3 = a2 + kstepA; const char* b3 = b2 + kstep;
            if (last && has_next) S.a_ready(nxt);
            if constexpr (SP2) {
            PG8_LDB(B0, 0, 0); PG8_LDB(B1, 0, 1); PG8_SCHED; PG8_LDA(At, 0, 0); PG8_STAGE(PG8_SA(1, 1), a1 + hstepA, voffA);
            PG8_WAIT_V(8); PG8_WAIT_L(0); PG8_BAR; PG8_MMA(0, 0, At, B0); PG8_MMA(0, 1, At, B1); PG8_BAR; PG8_SCHED;
            PG8_LDA(At, 0, 1); PG8_STAGE(PG8_SB(0, 0), b2, voffB); PG8_STAGE(PG8_SB(0, 1), b2 + hstep, voffB); PG8_STAGE(PG8_SA(0, 0), a2, voffA);
            PG8_WAIT_V(8); PG8_WAIT_L(0); PG8_BAR; PG8_MMA(1, 0, At, B0); PG8_MMA(1, 1, At, B1); PG8_BAR; PG8_SCHED;
            PG8_LDB(B0, 1, 0); PG8_LDB(B1, 1, 1); PG8_SCHED; PG8_LDA(At, 1, 0); PG8_STAGE(PG8_SA(0, 1), a2 + hstepA, voffA);
            PG8_WAIT_V(8); PG8_WAIT_L(0); PG8_BAR; PG8_MMA(0, 0, At, B0); PG8_MMA(0, 1, At, B1); PG8_BAR; PG8_SCHED;
            PG8_LDA(At, 1, 1); PG8_STAGE(PG8_SB(1, 0), b3, voffB); PG8_STAGE(PG8_SB(1, 1), b3 + hstep, voffB); PG8_STAGE(PG8_SA(1, 0), a3, voffA);
            PG8_WAIT_V(8); PG8_WAIT_L(0); PG8_BAR; PG8_MMA(1, 0, At, B0); PG8_MMA(1, 1, At, B1); PG8_BAR; PG8_SCHED;
            } else {
            PG8_LDB(B0, 0, 0); PG8_SCHED; PG8_LDA(At, 0, 0); PG8_STAGE(PG8_SA(1, 1), a1 + hstepA, voffA);
            PG8_WAIT_L(8); PG8_BAR; PG8_WAIT_L(0); PG8_MMA(0, 0, At, B0); PG8_BAR; PG8_SCHED;
            PG8_LDB(B1, 0, 1); PG8_STAGE(PG8_SB(0, 0), b2, voffB);
            PG8_BAR; PG8_WAIT_L(0); PG8_MMA(0, 1, At, B1); PG8_BAR;
            PG8_LDA(At, 0, 1); PG8_STAGE(PG8_SA(0, 0), a2, voffA);
            PG8_BAR; PG8_WAIT_L(0); PG8_MMA(1, 0, At, B0); PG8_BAR; PG8_SCHED;
            PG8_STAGE(PG8_SB(0, 1), b2 + hstep, voffB);
            PG8_WAIT_V(6); PG8_BAR; PG8_MMA(1, 1, At, B1); PG8_BAR;
            PG8_LDB(B0, 1, 0); PG8_SCHED; PG8_LDA(At, 1, 0); PG8_STAGE(PG8_SA(0, 1), a2 + hstepA, voffA);
            PG8_WAIT_L(8); PG8_BAR; PG8_WAIT_L(0); PG8_MMA(0, 0, At, B0); PG8_BAR; PG8_SCHED;
            PG8_LDB(B1, 1, 1); PG8_STAGE(PG8_SB(1, 0), b3, voffB);
            PG8_BAR; PG8_WAIT_L(0); PG8_MMA(0, 1, At, B1); PG8_BAR;
            PG8_LDA(At, 1, 1); PG8_STAGE(PG8_SA(1, 0), a3, voffA);
            PG8_BAR; PG8_WAIT_L(0); PG8_MMA(1, 0, At, B0); PG8_BAR; PG8_SCHED;
            PG8_STAGE(PG8_SB(1, 1), b3 + hstep, voffB);
            PG8_WAIT_V(6); PG8_BAR; PG8_MMA(1, 1, At, B1); PG8_BAR;
            }
        }
        if constexpr (ALIGN_EPI) { if (wr == 0) PG8_BAR; }
        if constexpr (!Epi::AFTER_DRAIN) { E(acc, cur, wr, wc, fr, fq);
#ifdef EPI_TWICE
            if constexpr (Epi::PERM) { asm volatile("" ::: "memory"); E(acc, cur, wr, wc, fr, fq); }
#endif
            S.done(cur); }
        if (!has_next) break;
#pragma unroll
        for (int a = 0; a < 2; ++a)
#pragma unroll
            for (int b = 0; b < 2; ++b)
#pragma unroll
                for (int m = 0; m < 4; ++m)
#pragma unroll
                    for (int n = 0; n < 2; ++n) acc[a][b][m][n] = (f32x4){0.f, 0.f, 0.f, 0.f};
        cur = nxt; cA = nA; cB = nB; ++ui;
        if constexpr (ALIGN_EPI) { if (wr == 1) PG8_BAR; }
    }
    PG8_WAIT_V(0);
    if constexpr (!ALIGN_EPI) { if (wr == 0) PG8_BAR; }
    PG8_BAR;
    if constexpr (Epi::AFTER_DRAIN) { E.fused(acc, cur, wr, wc, fr, fq, lds, wid, lane); S.done(cur); }
#undef PG8_SA
#undef PG8_SB
#undef PG8_STAGE
#undef PG8_LDA
#undef PG8_LDB
#undef PG8_MMA
#undef PG8_WAIT_V
#undef PG8_WAIT_L
#undef PG8_BAR
#undef PG8_SCHED
}
}

#else
namespace pg8 {
typedef unsigned short bf16_t;
constexpr int BM = 256, BK = 64, HALF = 128, NXCD = 8, WGM = 4;
struct Unit { int pm, pn; };
struct Gemm { const bf16_t* A; const bf16_t* Bt; int M, N, K; };
struct StaticOrder {
    int nM, nN, nwg, G, c, wv;
    void init(int M, int N, int G_, int c_) { nM = M / BM; nN = N / BM; nwg = nM * nN; G = G_; c = c_; }
    bool next(int i, Unit& u) const {
        const long L = (long)i * G + c; if (L >= nwg) return false;
        int wgid = (int)L; { const int q = nwg / NXCD, r = nwg % NXCD, xcd = wgid % NXCD, off = wgid / NXCD; wgid = (xcd < r ? xcd * (q + 1) : r * (q + 1) + (xcd - r) * q) + off; }
        const int nig = WGM * nN, gid = wgid / nig, fm = gid * WGM, gsz = (nM - fm) < WGM ? (nM - fm) : WGM;
        u.pm = fm + ((wgid % nig) % gsz); u.pn = (wgid % nig) / gsz; return true;
    }
};
DEV unsigned cvt_pk_bf16(float lo, float hi) { return pk2(lo, hi); }
template <class Epi, class Sched, bool A_ = false, bool B_ = false>
static void gemm_phase(unsigned char*, const Gemm g, const Sched& S, const Epi& E) {
    const int tid = threadIdx.x, wid = tid >> 6, lane = tid & 63, wr = wid >> 2, wc = wid & 3, fr = lane & 15, fq = lane >> 4;
    Unit u;
    for (int ui = 0; S.next(ui, u); ++ui) {
        f32x4 acc[2][2][4][2];
        for (int ai = 0; ai < 2; ++ai) for (int bj = 0; bj < 2; ++bj) for (int m = 0; m < 4; ++m) for (int n = 0; n < 2; ++n) for (int j = 0; j < 4; ++j) {
            const int row = 256 * u.pm + 128 * ai + 64 * wr + (Epi::ROWPERM ? 4 * fr + m : 16 * m + fr);
            const int col = Epi::PERM ? (256 * u.pn + 128 * bj + 32 * wc + 8 * fq + 4 * n + j) : (256 * u.pn + 128 * bj + 32 * wc + 16 * n + 4 * fq + j);
            const bf16_t* a = g.A + (size_t)row * g.K; const bf16_t* b = g.Bt + (size_t)col * g.K; double s = 0;
            for (int k = 0; k < g.K; ++k) { const bf16_t av = Epi::ATILED ? g.A[(((size_t)(row >> 8) * (g.K / 64) + (k >> 6)) * 256 + (row & 255)) * 64 + (k & 63)] : a[k]; s += (double)bf2f(av) * (double)bf2f(b[k]); }
            acc[ai][bj][m][n][j] = (float)s; }
        E(acc, u, wr, wc, fr, fq);
    }
}
}
#endif
#ifndef PG8_SP2
#define PG8_SP2 true
#endif
#ifndef PG8_ALIGN
#define PG8_ALIGN true
#endif

struct Ctx {
    unsigned char* lds;
#ifndef CPU_EMU
    unsigned char* lds_raw_;
#endif
    const float* const* in;
    int wave, G, bid;
};
#define CWS ((unsigned char*)(c.in[30]))
#define COUT ((float*)(c.in[29]))
#ifdef CPU_EMU
#define CTID ((int)threadIdx.x)
#define CLANE ((int)threadIdx.x & 63)
#else
#define CTID (c.wave * 64 + lane_id_())
#define CLANE (lane_id_())
#endif
enum { I_XP = 0, I_XS, I_PP, I_PS, I_SGLA, I_SGDN, I_CGDN, I_SHG, I_CFFN, I_NMIX, I_WIN, I_WGG, I_BGG, I_GLAN, I_WGC, I_ALOG, I_DTB, I_GDNN, I_HLB, I_HGN,
       I_WOUT, I_NFFN, I_WUP, I_WFC, I_WDN, I_NPLE, I_WPG, I_WPP, I_NFIN };

DEV size_t proj_row(int row) { return ((size_t)(row >> 8) * (NBIG / 256) * 256 + (row & 255)) * 256; }
DEV size_t proj_col(int col) { return (size_t)(col >> 8) * 65536 + (col & 255); }
struct EpiProj {
    static constexpr bool PERM = true, AFTER_DRAIN = false, ROWPERM = false, ATILED = false;
    bf16* P; float* PSM; const ssq_t* ss;
    DEVM void operator()(const f32x4 (&acc)[2][2][4][2], const pg8::Unit& u, int wr, int wc, int fr, int fq) const {
        const int row0 = u.pm * 256 + wr * 64 + fr;
        if (u.pn < NBIG / 256) {
            const int col0 = u.pn * 256 + wc * 32 + 8 * fq;
#pragma unroll
            for (int ai = 0; ai < 2; ++ai)
#pragma unroll
                for (int m = 0; m < 4; ++m) { bf16* rowp = P + proj_row(row0 + ai * 128 + m * 16) + proj_col(col0); const float rs = rstd_of(ss, row0 + ai * 128 + m * 16);
#pragma unroll
                    for (int bj = 0; bj < 2; ++bj) { const f32x4 v0 = acc[ai][bj][m][0] * rs, v1 = acc[ai][bj][m][1] * rs; u32x4 w;
                        w.x = pg8::cvt_pk_bf16(v0[0], v0[1]); w.y = pg8::cvt_pk_bf16(v0[2], v0[3]); w.z = pg8::cvt_pk_bf16(v1[0], v1[1]); w.w = pg8::cvt_pk_bf16(v1[2], v1[3]);
                        *(u32x4*)(rowp + bj * 128) = w; } }
        } else if (wc < 2) {
#pragma unroll
            for (int ai = 0; ai < 2; ++ai)
#pragma unroll
                for (int m = 0; m < 4; ++m) { float* rowp = PSM + (size_t)(row0 + ai * 128 + m * 16) * 64 + wc * 32 + 8 * fq; const float rs = rstd_of(ss, row0 + ai * 128 + m * 16);
                    *(f32x4*)rowp = acc[ai][0][m][0] * rs; *(f32x4*)(rowp + 4) = acc[ai][0][m][1] * rs; }
        }
    }
};
struct EpiBf16Out {
    static constexpr bool PERM = true, AFTER_DRAIN = false, ROWPERM = false, ATILED = false;
    bf16* O; int ldc; const ssq_t* ss;
    DEVM void operator()(const f32x4 (&acc)[2][2][4][2], const pg8::Unit& u, int wr, int wc, int fr, int fq) const {
        const int row0 = u.pm * 256 + wr * 64 + fr, col0 = u.pn * 256 + wc * 32 + 8 * fq;
#pragma unroll
        for (int ai = 0; ai < 2; ++ai)
#pragma unroll
            for (int m = 0; m < 4; ++m) { bf16* rowp = O + (size_t)(row0 + ai * 128 + m * 16) * ldc + col0; const float rs = ss ? rstd_of(ss, row0 + ai * 128 + m * 16) : 1.0f;
#pragma unroll
                for (int bj = 0; bj < 2; ++bj) { const f32x4 v0 = acc[ai][bj][m][0] * rs, v1 = acc[ai][bj][m][1] * rs; u32x4 w;
                    w.x = pg8::cvt_pk_bf16(v0[0], v0[1]); w.y = pg8::cvt_pk_bf16(v0[2], v0[3]); w.z = pg8::cvt_pk_bf16(v1[0], v1[1]); w.w = pg8::cvt_pk_bf16(v1[2], v1[3]);
                    *(u32x4*)(rowp + bj * 128) = w; } }
    }
};
template <int MODE  > struct EpiF32 {
    static constexpr bool PERM = false, AFTER_DRAIN = false, ROWPERM = false, ATILED = false;
    float* C; int ldc; const float* Gm;
    bf16* XB; ssq_t* ssout; const ssq_t* ssin;
    DEVM void operator()(const f32x4 (&acc)[2][2][4][2], const pg8::Unit& u, int wr, int wc, int fr, int fq) const {
        const int row0 = u.pm * 256 + wr * 64 + fr, col0 = u.pn * 256 + wc * 32 + 4 * fq;
        float sqs[8];
#pragma unroll
        for (int ai = 0; ai < 2; ++ai)
#pragma unroll
            for (int m = 0; m < 4; ++m) { const int row = row0 + ai * 128 + m * 16; const size_t off = (size_t)row * ldc + col0; float sq = 0.f; float rs = 1.f;
                if (MODE == 2) rs = rstd_of(ssin, row);
#pragma unroll
                for (int bj = 0; bj < 2; ++bj)
#pragma unroll
                    for (int n = 0; n < 2; ++n) { const size_t o2 = off + bj * 128 + n * 16; f32x4 v = acc[ai][bj][m][n];
                        if (MODE == 1) v = v + *(const f32x4*)(C + o2);
                        if (MODE == 2) { const f32x4 g = *(const f32x4*)(Gm + o2), c0 = *(const f32x4*)(C + o2);
                            v = (f32x4){c0[0] + sigmoidf_(v[0] * rs) * g[0], c0[1] + sigmoidf_(v[1] * rs) * g[1], c0[2] + sigmoidf_(v[2] * rs) * g[2], c0[3] + sigmoidf_(v[3] * rs) * g[3]}; }
                        *(f32x4*)(C + o2) = v;
                        if (MODE != 0) { u32x2 w; w.x = pk2(v[0], v[1]); w.y = pk2(v[2], v[3]); *(u32x2*)(XB + o2) = w; sq += (v[0] * v[0] + v[1] * v[1]) + (v[2] * v[2] + v[3] * v[3]); } }
                sqs[ai * 4 + m] = sq;
#ifndef CPU_EMU
                if (MODE != 0) asm volatile("" ::: "memory");
#endif
            }
        if (MODE != 0) {
#pragma unroll
            for (int k = 0; k < 8; ++k) { float sq = sqs[k]; sq += SHFL_XOR(sq, 16); sq += SHFL_XOR(sq, 32);
                if (fq == 0) atomic_addf(ssout + row0 + (k >> 2) * 128 + (k & 3) * 16, sq); } }
    }
};

template <int MODE, bool ATILED_ = false> struct EpiRes {
    static constexpr bool PERM = true, AFTER_DRAIN = false, ROWPERM = false, ATILED = ATILED_;
    const bf16* Rin; bf16* Rout; int ldc; const bf16* Gm; ssq_t* ssout; const ssq_t* ssin;
    DEVM void operator()(const f32x4 (&acc)[2][2][4][2], const pg8::Unit& u, int wr, int wc, int fr, int fq) const {
        const int row0 = u.pm * 256 + wr * 64 + fr, col0 = u.pn * 256 + wc * 32 + 8 * fq;
        float sqs[8];
#pragma unroll
        for (int ai = 0; ai < 2; ++ai)
#pragma unroll
            for (int m = 0; m < 4; ++m) { const int row = row0 + ai * 128 + m * 16; const size_t off = (size_t)row * ldc + col0; float sq = 0.f; float rs = 1.f;
                if (MODE == 2) rs = rstd_of(ssin, row);
#pragma unroll
                for (int bj = 0; bj < 2; ++bj) { const size_t o2 = off + bj * 128; f32x4 v0 = acc[ai][bj][m][0], v1 = acc[ai][bj][m][1];
                    const u32x4 cin = *(const u32x4*)(Rin + o2); const f32x4 c0 = unpack4((u32x2){cin.x, cin.y}), c1 = unpack4((u32x2){cin.z, cin.w});
                    if (MODE == 1) { v0 = v0 + c0; v1 = v1 + c1; }
                    if (MODE == 2) { const u32x4 gin = *(const u32x4*)(Gm + o2); const f32x4 g0 = unpack4((u32x2){gin.x, gin.y}), g1 = unpack4((u32x2){gin.z, gin.w});
                        v0 = (f32x4){c0[0] + sigmoidf_(v0[0] * rs) * g0[0], c0[1] + sigmoidf_(v0[1] * rs) * g0[1], c0[2] + sigmoidf_(v0[2] * rs) * g0[2], c0[3] + sigmoidf_(v0[3] * rs) * g0[3]};
                        v1 = (f32x4){c1[0] + sigmoidf_(v1[0] * rs) * g1[0], c1[1] + sigmoidf_(v1[1] * rs) * g1[1], c1[2] + sigmoidf_(v1[2] * rs) * g1[2], c1[3] + sigmoidf_(v1[3] * rs) * g1[3]}; }
                    u32x4 w; w.x = pk2(v0[0], v0[1]); w.y = pk2(v0[2], v0[3]); w.z = pk2(v1[0], v1[1]); w.w = pk2(v1[2], v1[3]); *(u32x4*)(Rout + o2) = w;
                    const f32x4 r0 = unpack4((u32x2){w.x, w.y}), r1 = unpack4((u32x2){w.z, w.w});
                    sq += ((r0[0] * r0[0] + r0[1] * r0[1]) + (r0[2] * r0[2] + r0[3] * r0[3])) + ((r1[0] * r1[0] + r1[1] * r1[1]) + (r1[2] * r1[2] + r1[3] * r1[3])); }
                sqs[ai * 4 + m] = sq;
#ifndef CPU_EMU
                asm volatile("" ::: "memory");
#endif
            }
#pragma unroll
        for (int k = 0; k < 8; ++k) { float sq = sqs[k]; sq += SHFL_XOR(sq, 16); sq += SHFL_XOR(sq, 32);
            if (fq == 0) atomic_addf(ssout + row0 + (k >> 2) * 128 + (k & 3) * 16, sq); }
    }
};

DEV size_t act_off(int row, int col) { return (((size_t)(row >> 8) * (D_FF / 64) + (col >> 6)) * 256 + (row & 255)) * 64 + (col & 63); }
template <int L> struct EpiUpAct {
    static constexpr bool PERM = true, AFTER_DRAIN = false, ROWPERM = true, ATILED = false;
    const float* const* in;
    DEVM void operator()(const f32x4 (&acc)[2][2][4][2], const pg8::Unit& u, int wr, int wc, int fr, int fq) const {
        unsigned char* const ws = (unsigned char*)in[30]; const ssq_t* const ss = (const ssq_t*)(ws + WS_SS) + (size_t)(3 * L + 1) * M; const float* const wf = in[I_WFC] + (size_t)L * FCONV * NUP;
        const int c8 = u.pn * 128 + wc * 32 + 8 * fq;
        if (u.pm >= MP / 256) {
#pragma unroll
            for (int ai = 0; ai < 2; ++ai)
#pragma unroll
                for (int m = 0; m < 4; ++m) { const int row = u.pm * 256 + ai * 128 + wr * 64 + 4 * fr + m; const float rs = rstd_of(ss, row);
#pragma unroll
                    for (int bj = 0; bj < 2; ++bj) { const f32x4 v0 = acc[ai][bj][m][0] * rs, v1 = acc[ai][bj][m][1] * rs; u32x4 w;
                        w.x = pk2(v0[0], v0[1]); w.y = pk2(v0[2], v0[3]); w.z = pk2(v1[0], v1[1]); w.w = pk2(v1[2], v1[3]);
                        *(u32x4*)((bf16*)(ws + WS_UP) + (size_t)row * NUP + bj * D_FF + c8) = w; } }
            return;
        }
        const bool edge0 = fr == 0, edge = edge0 || fr == 15;
#pragma unroll
        for (int ai = 0; ai < 2; ++ai) {
            const int B = u.pm * 4 + ai * 2 + wr, rowb = 64 * B + 4 * fr;
            float rs[4];
#pragma unroll
            for (int m = 0; m < 4; ++m) rs[m] = rstd_of(ss, rowb + m);
            unsigned ow[4][4];
            bf16* const sp = (bf16*)(ws + WS_SIDE) + ((size_t)B * 4 + (edge0 ? 0 : 2)) * NUP + c8;
#pragma unroll
            for (int n = 0; n < 2; ++n) {
                f32x4 wg[3], wv[3];
#pragma unroll
                for (int t = 0; t < 3; ++t) { wg[t] = *(const f32x4*)(wf + (size_t)t * NUP + c8 + 4 * n); wv[t] = *(const f32x4*)(wf + (size_t)t * NUP + D_FF + c8 + 4 * n); }
                float o[4][4], rg[2][4], rv[2][4];
#pragma unroll
                for (int jp = 0; jp < 2; ++jp) {
                    f32x2 xg[4], xv[4];
#pragma unroll
                    for (int m = 0; m < 4; ++m) { xg[m] = (f32x2){acc[ai][0][m][n][2 * jp], acc[ai][0][m][n][2 * jp + 1]} * rs[m]; xv[m] = (f32x2){acc[ai][1][m][n][2 * jp], acc[ai][1][m][n][2 * jp + 1]} * rs[m]; }
                    const f32x2 pg3 = (f32x2){ROW_SHR1(xg[3][0]), ROW_SHR1(xg[3][1])}, pg2 = (f32x2){ROW_SHR1(xg[2][0]), ROW_SHR1(xg[2][1])};
                    const f32x2 pv3 = (f32x2){ROW_SHR1(xv[3][0]), ROW_SHR1(xv[3][1])}, pv2 = (f32x2){ROW_SHR1(xv[2][0]), ROW_SHR1(xv[2][1])};
                    const f32x2 w0 = (f32x2){wg[0][2 * jp], wg[0][2 * jp + 1]}, w1 = (f32x2){wg[1][2 * jp], wg[1][2 * jp + 1]}, w2 = (f32x2){wg[2][2 * jp], wg[2][2 * jp + 1]};
                    const f32x2 u0 = (f32x2){wv[0][2 * jp], wv[0][2 * jp + 1]}, u1 = (f32x2){wv[1][2 * jp], wv[1][2 * jp + 1]}, u2 = (f32x2){wv[2][2 * jp], wv[2][2 * jp + 1]};
                    f32x2 yg[4], yv[4];
                    yg[0] = w2 * xg[0] + w1 * pg3 + w0 * pg2; yg[1] = w2 * xg[1] + w1 * xg[0] + w0 * pg3; yg[2] = w2 * xg[2] + w1 * xg[1] + w0 * xg[0]; yg[3] = w2 * xg[3] + w1 * xg[2] + w0 * xg[1];
                    yv[0] = u2 * xv[0] + u1 * pv3 + u0 * pv2; yv[1] = u2 * xv[1] + u1 * xv[0] + u0 * pv3; yv[2] = u2 * xv[2] + u1 * xv[1] + u0 * xv[0]; yv[3] = u2 * xv[3] + u1 * xv[2] + u0 * xv[1];
#pragma unroll
                    for (int m = 0; m < 4; ++m) { const f32x2 sg_ = (f32x2){sigmoidf_(yg[m][0]), sigmoidf_(yg[m][1])}; const f32x2 r = yg[m] * sg_ * yv[m]; o[m][2 * jp] = r[0]; o[m][2 * jp + 1] = r[1]; }
#pragma unroll
                    for (int e = 0; e < 2; ++e) { rg[0][2 * jp + e] = edge0 ? xg[0][e] : xg[2][e]; rg[1][2 * jp + e] = edge0 ? xg[1][e] : xg[3][e]; rv[0][2 * jp + e] = edge0 ? xv[0][e] : xv[2][e]; rv[1][2 * jp + e] = edge0 ? xv[1][e] : xv[3][e]; }
                }
#pragma unroll
                for (int m = 0; m < 4; ++m) { ow[m][2 * n] = pk2(o[m][0], o[m][1]); ow[m][2 * n + 1] = pk2(o[m][2], o[m][3]); }
                if (edge) {
#pragma unroll
                    for (int q = 0; q < 2; ++q) { u32x2 a, b; a.x = pk2(rg[q][0], rg[q][1]); a.y = pk2(rg[q][2], rg[q][3]); b.x = pk2(rv[q][0], rv[q][1]); b.y = pk2(rv[q][2], rv[q][3]);
                        *(u32x2*)(sp + (size_t)q * NUP + 4 * n) = a; *(u32x2*)(sp + (size_t)q * NUP + D_FF + 4 * n) = b; } }
            }
#pragma unroll
            for (int m = 0; m < 4; ++m) { u32x4 w; w.x = ow[m][0]; w.y = ow[m][1]; w.z = ow[m][2]; w.w = ow[m][3]; *(u32x4*)((bf16*)(ws + WS_ACT) + act_off(rowb + m, c8)) = w; }
#ifndef CPU_EMU
            asm volatile("" ::: "memory");
#endif
        }
    }
};

DEV int map_in(int n) {
    if (n < C_DQ) return n;
    if (n < C_HQ) return n + RANK;
    if (n < NBIG) return n + RANK + 2 * GDN_H;
    const int s = n - NBIG;
    if (s < RANK) return C_DQ + s;
    if (s < NSMALL) return O_DB + (s - RANK);
    return -1;
}
DEV f32x4 ld_nt4(const float* p) {
#ifdef CPU_EMU
    return *(const f32x4*)p;
#else
    return __builtin_nontemporal_load((const f32x4*)p);
#endif
}
DEV int map_up(int n) { return ((n >> 7) & 1) * D_FF + 128 * (n >> 8) + (n & 127); }
DEV void transpose_item(const float* W, int K, int Nsrc, bf16* WT, int kind, const float* gain, unsigned* scr, int kb, int nb, int lane) {
    const int k0 = 64 * kb, n0 = 64 * nb, ks = lane >> 4, n4 = lane & 15; const int ncol = n0 + 4 * n4; const int sc = kind == 1 ? map_in(ncol) : kind == 2 ? map_up(ncol) : ncol;
    f32x4 v[16];
    const float* src = W + (size_t)(k0 + 2 * ks) * Nsrc + (sc >= 0 ? sc : 0);
#pragma unroll
    for (int i = 0; i < 16; ++i) v[i] = ld_nt4(src + (size_t)(8 * (i >> 1) + (i & 1)) * Nsrc);
    if (sc < 0) {
#pragma unroll
        for (int i = 0; i < 16; ++i) v[i] = (f32x4){0.f, 0.f, 0.f, 0.f}; }
    if (gain) {
#pragma unroll
        for (int i = 0; i < 16; ++i) v[i] = v[i] * gain[k0 + 2 * ks + 8 * (i >> 1) + (i & 1)]; }
#pragma unroll
    for (int m = 0; m < 8; ++m) {
#pragma unroll
        for (int e = 0; e < 4; ++e) scr[(4 * n4 + e) * 33 + 4 * m + ks] = pk2(v[2 * m][e], v[2 * m + 1][e]); }
    WAVE_SYNC();
    const int c = lane & 7;
#pragma unroll
    for (int j = 0; j < 8; ++j) { const int n = (lane >> 3) + 8 * j; const unsigned* sp = scr + n * 33 + 4 * c;
        u32x4 o; o.x = sp[0]; o.y = sp[1]; o.z = sp[2]; o.w = sp[3];
        *(u32x4*)(WT + (size_t)(n0 + n) * K + k0 + 8 * c) = o; }
    WAVE_SYNC();
}
DEV void transpose_matrix(Ctx& c, const float* W, int K, int Nsrc, int Ndst, bf16* WT, int kind, const float* gain, int gw, int NGW) {
    unsigned* scr = (unsigned*)(c.lds + c.wave * 16384);
    const int nblk = Ndst / 64, nitems = (K / 64) * nblk;
    for (int it = gw; it < nitems; it += NGW) transpose_item(W, K, Nsrc, WT, kind, gain, scr, it / nblk, it % nblk, CLANE);
}
DEV void conv_win(Ctx& c, int l, int gw, int NGW) { transpose_matrix(c, c.in[I_WIN] + (size_t)l * D_MODEL * N_IN, D_MODEL, N_IN, N1, (bf16*)(CWS + WS_WIN + l * al4k(SZ_WIN)), 1, c.in[I_NMIX] + (size_t)l * D_MODEL, gw, NGW); }
DEV void conv_wout(Ctx& c, int l, int gw, int NGW) { transpose_matrix(c, c.in[I_WOUT] + (size_t)l * D_MIX * D_MODEL, D_MIX, D_MODEL, D_MODEL, (bf16*)(CWS + WS_WOUT + l * al4k(SZ_WOUT)), 0, nullptr, gw, NGW); }
DEV void conv_wup(Ctx& c, int l, int gw, int NGW) { transpose_matrix(c, c.in[I_WUP] + (size_t)l * D_MODEL * NUP, D_MODEL, NUP, NUP, (bf16*)(CWS + WS_WUP + l * al4k(SZ_WUP)), 2, c.in[I_NFFN] + (size_t)l * D_MODEL, gw, NGW); }
DEV void conv_wdn(Ctx& c, int l, int gw, int NGW) { transpose_matrix(c, c.in[I_WDN] + (size_t)l * D_FF * D_MODEL, D_FF, D_MODEL, D_MODEL, (bf16*)(CWS + WS_WDN + l * al4k(SZ_WDN)), 0, nullptr, gw, NGW); }
DEV void conv_wpg(Ctx& c, int l, int gw, int NGW) { transpose_matrix(c, c.in[I_WPG] + (size_t)l * D_MODEL * D_MODEL, D_MODEL, D_MODEL, D_MODEL, (bf16*)(CWS + WS_WPG + l * al4k(SZ_WPG)), 0, c.in[I_NPLE] + (size_t)l * D_MODEL, gw, NGW); }
DEV void conv_wpp(Ctx& c, int l, int gw, int NGW) { transpose_matrix(c, c.in[I_WPP] + (size_t)l * D_PLE * D_MODEL, D_PLE, D_MODEL, D_MODEL, (bf16*)(CWS + WS_WPP + l * al4k(SZ_WPP)), 0, nullptr, gw, NGW); }
DEV bool conv_side(Ctx& c, int k) {
    constexpr int NB_IN = N1 / 64, N_IN_ITEMS = (D_MODEL / 64) * NB_IN, NB_PP = D_MODEL / 64, N_PP_ITEMS = (D_PLE / 64) * NB_PP;
    constexpr int TOTAL = (DEPTH - 1) * N_IN_ITEMS + DEPTH * N_PP_ITEMS;
    const int NGW = c.G * 8; const long base = (long)k * NGW; if (base >= TOTAL) return false;
    int it = (int)base + c.bid * 8 + c.wave; unsigned* scr = (unsigned*)(c.lds + c.wave * 16384);
    if (it < TOTAL) {
        if (it < (DEPTH - 1) * N_IN_ITEMS) { const int l = 1 + it / N_IN_ITEMS, r = it % N_IN_ITEMS;
            transpose_item(c.in[I_WIN] + (size_t)l * D_MODEL * N_IN, D_MODEL, N_IN, (bf16*)(CWS + WS_WIN + l * al4k(SZ_WIN)), 1, c.in[I_NMIX] + (size_t)l * D_MODEL, scr, r / NB_IN, r % NB_IN, CLANE); }
        else { it -= (DEPTH - 1) * N_IN_ITEMS; const int l = it / N_PP_ITEMS, r = it % N_PP_ITEMS;
            transpose_item(c.in[I_WPP] + (size_t)l * D_PLE * D_MODEL, D_PLE, D_MODEL, (bf16*)(CWS + WS_WPP + l * al4k(SZ_WPP)), 0, nullptr, scr, r / NB_PP, r % NB_PP, CLANE); }
    }
    return true;
}
DEV void first_row(const float* xrow, bf16* xb, ssq_t* ss, int lane) {
    constexpr int NJ = D_MODEL / 256; float s = 0.f;
#pragma unroll
    for (int j = 0; j < NJ; ++j) { const f32x4 v = *(const f32x4*)(xrow + 4 * lane + 256 * j); u32x2 w; w.x = pk2(v[0], v[1]); w.y = pk2(v[2], v[3]); *(u32x2*)(xb + 4 * lane + 256 * j) = w;
        const f32x4 t = unpack4(w); s += (t[0] * t[0] + t[1] * t[1]) + (t[2] * t[2] + t[3] * t[3]); }
    s = wave_sum(s); if (lane == 0) *ss = (ssq_t)(s * 16777216.0f);
}
DEV void final_row(const bf16* hrow, const float* gain, float rs, float* y, int lane) {
    constexpr int NJ = D_MODEL / 256;
#pragma unroll
    for (int j = 0; j < NJ; ++j) { const f32x4 v = unpack4(*(const u32x2*)(hrow + 4 * lane + 256 * j)), g = *(const f32x4*)(gain + 4 * lane + 256 * j); *(f32x4*)(y + 4 * lane + 256 * j) = v * rs * g; }
}
DEV void phase_prologue(Ctx& c) {
    { const int gw0 = c.bid * 8 + c.wave, NGW0 = c.G * 8;
      conv_win(c, 0, gw0, NGW0); }
    const int gw = c.bid * 8 + c.wave, NGW = c.G * 8;
    for (int m = gw; m < M; m += NGW) {
        const float* xr = m < MP ? c.in[I_XP] + (size_t)m * D_MODEL : c.in[I_XS] + (size_t)(m - MP) * D_MODEL;
        first_row(xr, (bf16*)(CWS + WS_XN) + (size_t)m * D_MODEL, (ssq_t*)(CWS + WS_SS) + m, CLANE);
    }
    for (int i = c.bid * 512 + CTID; i < 3 * DEPTH * M; i += c.G * 512) ((ssq_t*)(CWS + WS_SS))[M + i] = 0ull;
    bf16* PE = (bf16*)(CWS + WS_PE);
    for (size_t i = (size_t)c.bid * 512 + CTID; i < (size_t)DEPTH * M * D_PLE / 4; i += (size_t)c.G * 512) {
        const size_t e = i * 4; const int l = (int)(e / ((size_t)M * D_PLE)); const size_t r = e % ((size_t)M * D_PLE); const int m = (int)(r / D_PLE), cc = (int)(r % D_PLE);
        const float* src = m < MP ? c.in[I_PP] + ((size_t)l * MP + m) * D_PLE + cc : c.in[I_PS] + ((size_t)l * MS + (m - MP)) * D_PLE + cc;
        const f32x4 v = *(const f32x4*)src; u32x2 w; w.x = pk2(v[0], v[1]); w.y = pk2(v[2], v[3]); *(u32x2*)(PE + e) = w;
    }
}
DEV void phase_final(Ctx& c) {
    const int gw = c.bid * 8 + c.wave, NGW = c.G * 8; const ssq_t* ss = (const ssq_t*)(CWS + WS_SS) + (size_t)(3 * DEPTH) * M;
    const bf16* R = (const bf16*)(CWS + ((DEPTH & 1) ? WS_XB1 : WS_XN));
    for (int m = gw; m < M; m += NGW) final_row(R + (size_t)m * D_MODEL, c.in[I_NFIN], rstd_of(ss, m), COUT + O_Y + (size_t)m * D_MODEL, CLANE);
}

struct Chunk { int row0, nvalid, seq, cpos0; bool sample; int sb; };
DEV Chunk chunk_of(int cid) {
    Chunk k;
    if (cid < NCHP) { k.row0 = cid * CHUNK; k.nvalid = CHUNK; k.seq = cid / CPS; k.cpos0 = (cid % CPS) * CHUNK; k.sample = false; k.sb = 0; }
    else { k.sb = cid - NCHP; k.row0 = MP + DEC_SEQ * k.sb; k.nvalid = DEC_SEQ; k.seq = BATCH + k.sb; k.cpos0 = 0; k.sample = true; }
    return k;
}
DEV int rec_u(int cid, int hid) { return cid < NCHP ? ((cid / CPS) * NHT + hid) * CPS + cid % CPS : NCHP * NHT + (cid - NCHP) * NHT + hid; }
DEV int rec_ug(int cid, int hg) { return cid < NCHP ? ((cid / CPS) * GDN_H + hg) * CPS + cid % CPS : NCHP * GDN_H + (cid - NCHP) * GDN_H + hg; }
constexpr int PF = 132;
constexpr int PA = 136, PK = 72;

DEV bf16x8 ldF(const bf16* p) { bf16x8 r; const u32x4 w = *(const u32x4*)p; __builtin_memcpy(&r, &w, 16); return r; }
DEV void tri_decode(int p, int& tt, int& st) { tt = p >= 6 ? 3 : p >= 3 ? 2 : p >= 1 ? 1 : 0; st = p - tt * (tt + 1) / 2; }
DEV void up_decode(int p, int& tt, int& st) { tt = p >= 5 ? 2 : p >= 3 ? 1 : 0; st = p >= 5 ? 3 : p >= 3 ? p - 1 : p + 1; }
DEV void m1_lin(Ctx& c, int layer, int cid, int hid, bool is_gla, int h) {
    bf16* QT = (bf16*)c.lds; bf16* KT = QT + 64 * PA; bf16* AQ = KT + 160 * PA; float* lrs = (float*)(c.lds + 70144); float* part = lrs + 1024;
    int tid_ = CTID, wave_ = c.wave; LAUNDER_V(tid_); LAUNDER_S(wave_);
    const Chunk ck = chunk_of(cid); const int u = rec_u(cid, hid); const int tid = tid_, lane = tid & 63, q = lane >> 4, r = lane & 15;
    const bf16* PROJ = (const bf16*)(CWS + WS_PROJ); const float* PSM = (const float*)(CWS + WS_PSM);
    const int d = tid & 127, tq = wave_ >> 1;
    if (is_gla && tid < 256) { const int t = tid >> 2, c4 = tid & 3; f32x4 v = (f32x4){0.f, 0.f, 0.f, 0.f};
        if (t < ck.nvalid) v = *(const f32x4*)(PSM + (size_t)(ck.row0 + t) * 64 + 4 * c4);
        *(f32x4*)(lrs + t * 16 + 4 * c4) = v; }
    float bgd = 0.f, wgr[RANK], lb = 0.f;
#pragma unroll
    for (int rr = 0; rr < RANK; ++rr) wgr[rr] = 0.f;
    if (is_gla) { bgd = c.in[I_BGG][(size_t)layer * GLA_KW + h * 128 + d]; const float* wg = c.in[I_WGG] + (size_t)layer * RANK * GLA_KW + h * 128 + d;
#pragma unroll
        for (int rr = 0; rr < RANK; ++rr) wgr[rr] = wg[(size_t)rr * GLA_KW]; }
    else { float mx = -3.0e38f; for (int j = 0; j < DEPTH; ++j) mx = fmaxf(mx, c.in[I_HLB][(size_t)j * HG_KW + h * 128 + d]);
        float den = 0.f, num = 0.f; for (int j = 0; j < DEPTH; ++j) { const float e = FEXP(c.in[I_HLB][(size_t)j * HG_KW + h * 128 + d] - mx); den += e; if (j >= 1 && j <= layer) num += e; }
        lb = num / den; }
    const int c1 = (is_gla ? C_GQ : C_HQ) + h * 128 + d, c2 = (is_gla ? C_GK : C_HF) + h * 128 + d;
    bf16 r1[16], r2[16];
#pragma unroll
    for (int i = 0; i < 16; ++i) { const int t = 16 * tq + i; const int tc = t < ck.nvalid ? t : ck.nvalid - 1; const bf16* pr = PROJ + proj_row(ck.row0 + tc); r1[i] = pr[proj_col(c1)]; r2[i] = pr[proj_col(c2)]; }
    __syncthreads();
    float qv[16], kv[16], bv[16]; float run = 0.f;
#pragma unroll
    for (int i = 0; i < 16; ++i) { const int t = 16 * tq + i; float qq = 0.f, kk_ = 0.f, g = 0.f;
        if (t < ck.nvalid) {
            if (is_gla) { qq = bf2f(r1[i]) * 0.08838834764831845f; kk_ = bf2f(r2[i]); float pre = bgd;
#pragma unroll
                for (int r4 = 0; r4 < RANK / 4; ++r4) { const f32x4 l4 = *(const f32x4*)(lrs + t * 16 + 4 * r4); pre += l4[0] * wgr[4 * r4] + l4[1] * wgr[4 * r4 + 1] + l4[2] * wgr[4 * r4 + 2] + l4[3] * wgr[4 * r4 + 3]; }
                g = logsigmoidf_(pre) * (1.0f / 16.0f); }
            else { const float z = bf2f(r2[i]); const float sg = sigmoidf_(z), f = fmaxf(lb, TINY) + (1.0f - lb) * sg;
                g = FLOG(f); kk_ = (1.0f - lb) * sigmoidf_(-z); qq = siluf_(bf2f(r1[i])); }
        }
        run += g; qv[i] = qq; kv[i] = kk_; bv[i] = run;
#ifndef CPU_EMU
        if ((i & 3) == 3) asm volatile("" ::: "memory");
#endif
    }
    part[tq * 128 + d] = run;
    __syncthreads();
    float off[4]; float total = 0.f, myoff = 0.f;
#pragma unroll
    for (int j = 0; j < 4; ++j) { off[j] = total; if (j == tq) myoff = total; total += part[j * 128 + d]; }
    bf16* QB = (bf16*)(CWS + WS_QB) + (size_t)u * 8192; bf16* KBT = (bf16*)(CWS + WS_KBT) + (size_t)u * 8192; float* DL = (float*)(CWS + WS_DL) + (size_t)u * 128;
    unsigned kb[8];
#pragma unroll
    for (int i = 0; i < 16; ++i) { const int t = 16 * tq + i; const float bt = myoff + bv[i];
        QT[t * PA + d] = (bf16)f2bf(qv[i] * FEXP(bv[i]));
        QB[t * 128 + d] = (bf16)f2bf(qv[i] * FEXP(bt));
        const unsigned kbt = f2bf(kv[i] * FEXP(total - bt)); if (i & 1) kb[i >> 1] |= kbt << 16; else kb[i >> 1] = kbt;
#pragma unroll
        for (int ib = 0; ib < 4; ++ib) if (ib >= tq) KT[(8 * ib * (ib + 1) + 16 * tq + i) * PA + d] = (bf16)f2bf(kv[i] * FEXP(fminf(off[ib] - bt, 80.f)));
#ifndef CPU_EMU
        if ((i & 3) == 3) asm volatile("" ::: "memory");
#endif
    }
    { u32x4 w0, w1; w0.x = kb[0]; w0.y = kb[1]; w0.z = kb[2]; w0.w = kb[3]; w1.x = kb[4]; w1.y = kb[5]; w1.z = kb[6]; w1.w = kb[7];
      *(u32x4*)(KBT + d * 64 + 16 * tq) = w0; *(u32x4*)(KBT + d * 64 + 16 * tq + 8) = w1; }
    if (tq == 0) DL[d] = FEXP(total);
    __syncthreads();
    for (int job = wave_; job < 16; job += 8) {
        if (job < 10) { int ti, tj; tri_decode(job, ti, tj); f32x4 acc = (f32x4){0.f, 0.f, 0.f, 0.f};
#pragma unroll
            for (int kk = 0; kk < 4; ++kk) acc = mfma16(ldF(QT + (16 * ti + r) * PA + 32 * kk + 8 * q), ldF(KT + (8 * ti * (ti + 1) + 16 * tj + r) * PA + 32 * kk + 8 * q), acc);
#pragma unroll
            for (int jj = 0; jj < 4; ++jj) AQ[(16 * ti + 4 * q + jj) * PK + 16 * tj + r] = (bf16)f2bf((tj < ti || r <= 4 * q + jj) ? acc[jj] : 0.f);
        } else { int ti, tj; up_decode(job - 10, ti, tj);
#pragma unroll
            for (int jj = 0; jj < 4; ++jj) AQ[(16 * ti + 4 * q + jj) * PK + 16 * tj + r] = (bf16)0; }
    }
    __syncthreads();
    { bf16* AQK = (bf16*)(CWS + WS_AQK) + (size_t)u * 4096; *(u32x4*)(AQK + (tid >> 3) * 64 + (tid & 7) * 8) = *(const u32x4*)(AQ + (tid >> 3) * PK + (tid & 7) * 8); }
    __syncthreads();
}
DEV void split2(f32x4 x0, f32x4 x1, bf16x8& hi, bf16x8& lo) {
    unsigned h[8], l[8];
#pragma unroll
    for (int j = 0; j < 4; ++j) { h[j] = f2bf(x0[j]); l[j] = f2bf(x0[j] - bf2f((bf16)h[j])); h[4 + j] = f2bf(x1[j]); l[4 + j] = f2bf(x1[j] - bf2f((bf16)h[4 + j])); }
    u32x4 wh, wl; wh.x = h[0] | (h[1] << 16); wh.y = h[2] | (h[3] << 16); wh.z = h[4] | (h[5] << 16); wh.w = h[6] | (h[7] << 16);
    wl.x = l[0] | (l[1] << 16); wl.y = l[2] | (l[3] << 16); wl.z = l[4] | (l[5] << 16); wl.w = l[6] | (l[7] << 16);
    __builtin_memcpy(&hi, &wh, 16); __builtin_memcpy(&lo, &wl, 16);
}
DEV bf16x8 ldA(const bf16* base, int P, int row, int kk, int q);
DEV void m1_gdn(Ctx& c, int layer, int cid, int hid, int hg) {
    unsigned char* RA = c.lds; unsigned char* RB = c.lds + 59904;
    float* wts = (float*)RA; bf16* RAW = (bf16*)(RA + 6144);
    bf16* Lh = (bf16*)RA; bf16* Ll = Lh + 64 * PK; bf16* TDh = Ll + 64 * PK; bf16* TDl = TDh + 64 * PK;
    float* AD = (float*)(RA + 36864); bf16* AQ = (bf16*)(RA + 41216);
    bf16* QN = (bf16*)RB; bf16* KN = QN + 64 * PA; float* VF = (float*)(RB + 34816);
    float* betav = (float*)(RB + 68608); float* bvec = betav + 64; float* eb = bvec + 64; float* ebl = eb + 64; float* gv = ebl + 64; float* ssp = gv + 64;
    constexpr int PR = 392;
    int tid_ = CTID, wave_ = c.wave; LAUNDER_V(tid_); LAUNDER_S(wave_);
    const Chunk ck = chunk_of(cid); const int u = rec_u(cid, hid), ug = rec_ug(cid, hg); const int tid = tid_, lane = tid & 63, q = lane >> 4, r = lane & 15;
    const bf16* PROJ = (const bf16*)(CWS + WS_PROJ); const float* PSM = (const float*)(CWS + WS_PSM);
    const float* wconv = c.in[I_WGC] + (size_t)layer * GCONV * GDN_QKV; const float* cache = c.in[I_CGDN] + ((size_t)layer * DEC_BATCH + ck.sb) * 3 * GDN_QKV;
    for (int i = tid; i < GCONV * 384; i += 512) { const int j = i / 384, cc = i % 384; wts[i] = wconv[(size_t)j * GDN_QKV + (cc >> 7) * GDN_KW + hg * 128 + (cc & 127)]; }
    { u32x4 rv[7]; bool ok[7];
#pragma unroll
      for (int k = 0; k < 7; ++k) { const int i = tid + 512 * k, rr = i / 48, ch = i % 48, tl = rr - (GCONV - 1);
          ok[k] = (i < 67 * 48) && (tl < ck.nvalid) && (ck.cpos0 + tl >= 0);
          const bf16* src = PROJ + proj_col(C_DQ + (ch >> 4) * GDN_KW + hg * 128 + (ch & 15) * 8);
          rv[k] = *(const u32x4*)(ok[k] ? src + proj_row(ck.row0 + tl) : src); }
#pragma unroll
      for (int k = 0; k < 7; ++k) { const int i = tid + 512 * k, rr = i / 48, ch = i % 48;
          if (i < 67 * 48) *(u32x4*)(RAW + rr * PR + ch * 8) = ok[k] ? rv[k] : (u32x4){0u, 0u, 0u, 0u}; } }
    __syncthreads();
    if (ck.sample) {
        for (int i = tid; i < 3 * 384; i += 512) { const int rr = i / 384, cc = i % 384; RAW[rr * PR + cc] = (bf16)f2bf(cache[(size_t)rr * GDN_QKV + (cc >> 7) * GDN_KW + hg * 128 + (cc & 127)]); }
        __syncthreads(); }
    float rr_[64]; float ss = 0.f; const int part = wave_, which = part >> 1, half = part & 1, col0 = which * 128 + half * 64;
    if (part < 6) { const int t = lane;
#pragma unroll
        for (int g8 = 0; g8 < 8; ++g8) { float acc[8];
#pragma unroll
            for (int e = 0; e < 8; ++e) acc[e] = 0.f;
#pragma unroll
            for (int j = 0; j < GCONV; ++j) { const u32x4 raw = *(const u32x4*)(RAW + (t + j) * PR + col0 + 8 * g8); const f32x4 wa = *(const f32x4*)(wts + j * 384 + col0 + 8 * g8), wb = *(const f32x4*)(wts + j * 384 + col0 + 8 * g8 + 4);
                const unsigned rw[4] = {raw.x, raw.y, raw.z, raw.w};
#pragma unroll
                for (int e = 0; e < 4; ++e) { const float w_lo = e < 2 ? wa[2 * e] : wb[2 * e - 4], w_hi = e < 2 ? wa[2 * e + 1] : wb[2 * e - 3];
                    acc[2 * e] += w_lo * bf2f((bf16)(rw[e] & 0xffff)); acc[2 * e + 1] += w_hi * bf2f((bf16)(rw[e] >> 16)); } }
#pragma unroll
            for (int e = 0; e < 8; ++e) { const float v = t < ck.nvalid ? siluf_(acc[e]) : 0.f; rr_[8 * g8 + e] = v; ss += v * v; }
#ifndef CPU_EMU
            asm volatile("" ::: "memory");
#endif
        }
        if (which < 2) ssp[part * 64 + t] = ss;
        else {
#pragma unroll
            for (int g4 = 0; g4 < 16; ++g4) *(f32x4*)(VF + t * PF + half * 64 + 4 * g4) = (f32x4){rr_[4 * g4], rr_[4 * g4 + 1], rr_[4 * g4 + 2], rr_[4 * g4 + 3]}; }
    } else if (part == 6) { const int t = lane; float be = 0.f, g = 0.f;
        if (t < ck.nvalid) { const float* ps = PSM + (size_t)(ck.row0 + t) * 64; be = sigmoidf_(ps[S_DB + hg]);
            g = -FEXP(c.in[I_ALOG][layer * GDN_H + hg]) * softplusf_(ps[S_DA + hg] + c.in[I_DTB][layer * GDN_H + hg]); }
        betav[t] = be; gv[t] = g;
        WAVE_SYNC();
        float bt = 0.f, tot = 0.f;
        for (int s_ = 0; s_ < 64; ++s_) { const float gs = gv[s_]; tot += gs; if (s_ <= t) bt += gs; }
        bvec[t] = bt; eb[t] = FEXP(bt); ebl[t] = FEXP(tot - bt);
    }
    __syncthreads();
    if (part < 4) { const int t = lane; const float scl = FRSQ(ssp[(2 * which) * 64 + t] + ssp[(2 * which + 1) * 64 + t] + EPS) * (which == 0 ? 0.08838834764831845f : 1.0f);
        bf16* dst = (which ? KN : QN) + t * PA + half * 64;
#pragma unroll
        for (int g8 = 0; g8 < 8; ++g8) { u32x4 w; w.x = pk2(rr_[8 * g8] * scl, rr_[8 * g8 + 1] * scl); w.y = pk2(rr_[8 * g8 + 2] * scl, rr_[8 * g8 + 3] * scl);
            w.z = pk2(rr_[8 * g8 + 4] * scl, rr_[8 * g8 + 5] * scl); w.w = pk2(rr_[8 * g8 + 6] * scl, rr_[8 * g8 + 7] * scl); *(u32x4*)(dst + 8 * g8) = w; } }
    __syncthreads();
    for (int i = tid; i < 2 * 64 * PK / 8; i += 512) *(u32x4*)(TDh + i * 8) = (u32x4){0u, 0u, 0u, 0u};
    for (int job = wave_; job < 26; job += 8) {
        if (job < 20) { const int type = job / 10; int tt, st; tri_decode(job % 10, tt, st); f32x4 acc = (f32x4){0.f, 0.f, 0.f, 0.f}; const bf16* Am = type ? QN : KN;
#pragma unroll
            for (int kk = 0; kk < 4; ++kk) acc = mfma16(ldF(Am + (16 * tt + r) * PA + 32 * kk + 8 * q), ldF(KN + (16 * st + r) * PA + 32 * kk + 8 * q), acc);
#pragma unroll
            for (int jj = 0; jj < 4; ++jj) { const int t = 16 * tt + 4 * q + jj, s_ = 16 * st + r; const float dec = s_ <= t ? FEXP(bvec[t] - bvec[s_]) : 0.f;
                if (type == 0) { const float val = s_ < t ? betav[t] * acc[jj] * dec : 0.f; const unsigned hi = f2bf(-val), lo = f2bf(-val - bf2f((bf16)hi));
                    Lh[t * PK + s_] = (bf16)hi; Ll[t * PK + s_] = (bf16)lo; if (tt == st) AD[(tt * 16 + 4 * q + jj) * 17 + r] = val; }
                else AQ[t * PK + s_] = (bf16)f2bf(acc[jj] * dec); }
        } else { int tt, st; up_decode(job - 20, tt, st);
#pragma unroll
            for (int jj = 0; jj < 4; ++jj) AQ[(16 * tt + 4 * q + jj) * PK + 16 * st + r] = (bf16)0; }
    }
    __syncthreads();
    if (wave_ == 0) { const int blk = lane >> 4, j = lane & 15; float tv[16];
#pragma unroll
        for (int rr = 0; rr < 16; ++rr) { float acc = rr == j ? 1.f : 0.f;
#pragma unroll
            for (int s_ = 0; s_ < rr; ++s_) acc -= AD[(blk * 16 + rr) * 17 + s_] * tv[s_];
            tv[rr] = acc; const unsigned hi = f2bf(acc), lo = f2bf(acc - bf2f((bf16)hi));
            TDh[(16 * blk + rr) * PK + 16 * blk + j] = (bf16)hi; TDl[(16 * blk + rr) * PK + 16 * blk + j] = (bf16)lo; }
    } else {
        bf16* QB = (bf16*)(CWS + WS_QB) + (size_t)u * 8192; bf16* KBT = (bf16*)(CWS + WS_KBT) + (size_t)u * 8192; bf16* AQK = (bf16*)(CWS + WS_AQK) + (size_t)u * 4096; float* DL = (float*)(CWS + WS_DL) + (size_t)u * 128;
        for (int it = tid - 64; it < 2560 + 128; it += 448) {
            if (it < 1024) { const int t = it >> 4, c16 = it & 15; const u32x4 w = *(const u32x4*)(QN + t * PA + c16 * 8); const float e = eb[t]; const unsigned ww[4] = {w.x, w.y, w.z, w.w}; u32x4 o;
                o.x = pk2(bf2f((bf16)(ww[0] & 0xffff)) * e, bf2f((bf16)(ww[0] >> 16)) * e); o.y = pk2(bf2f((bf16)(ww[1] & 0xffff)) * e, bf2f((bf16)(ww[1] >> 16)) * e);
                o.z = pk2(bf2f((bf16)(ww[2] & 0xffff)) * e, bf2f((bf16)(ww[2] >> 16)) * e); o.w = pk2(bf2f((bf16)(ww[3] & 0xffff)) * e, bf2f((bf16)(ww[3] >> 16)) * e);
                *(u32x4*)(QB + t * 128 + c16 * 8) = o; }
            else if (it < 2048) { const int i2 = it - 1024, dd = i2 >> 3, s8 = i2 & 7; float kvv[8];
#pragma unroll
                for (int e = 0; e < 8; ++e) kvv[e] = bf2f(KN[(8 * s8 + e) * PA + dd]) * ebl[8 * s8 + e];
                u32x4 o; o.x = pk2(kvv[0], kvv[1]); o.y = pk2(kvv[2], kvv[3]); o.z = pk2(kvv[4], kvv[5]); o.w = pk2(kvv[6], kvv[7]); *(u32x4*)(KBT + dd * 64 + 8 * s8) = o; }
            else if (it < 2560) { const int i2 = it - 2048; *(u32x4*)(AQK + (i2 >> 3) * 64 + (i2 & 7) * 8) = *(const u32x4*)(AQ + (i2 >> 3) * PK + (i2 & 7) * 8); }
            else DL[it - 2560] = eb[63];
        }
    }
    __syncthreads();
    { const bool vpart = wave_ < 4; const int n0 = 32 * (wave_ & 3);
      f32x4 R[4][2], X[4][2];
#pragma unroll
      for (int i = 0; i < 4; ++i)
#pragma unroll
        for (int nt = 0; nt < 2; ++nt)
#pragma unroll
            for (int jj = 0; jj < 4; ++jj) { const int t = 16 * i + 4 * q + jj, cc = n0 + 16 * nt + r; R[i][nt][jj] = vpart ? betav[t] * VF[t * PF + cc] : betav[t] * eb[t] * bf2f(KN[t * PA + cc]); }
      const f32x4 Z = (f32x4){0.f, 0.f, 0.f, 0.f};
#pragma unroll
      for (int i = 0; i < 4; ++i) {
          if (i >= 1) {
#pragma unroll
              for (int kk = 0; kk < (i == 3 ? 2 : 1); ++kk) { const bf16x8 Ah = ldA(Lh, PK, 16 * i + r, kk, q), Al = ldA(Ll, PK, 16 * i + r, kk, q);
#pragma unroll
                  for (int nt = 0; nt < 2; ++nt) { bf16x8 Bh, Bl; split2(X[2 * kk][nt], (2 * kk + 1 < i) ? X[2 * kk + 1][nt] : Z, Bh, Bl);
                      R[i][nt] = mfma16(Ah, Bh, R[i][nt]); R[i][nt] = mfma16(Ah, Bl, R[i][nt]); R[i][nt] = mfma16(Al, Bh, R[i][nt]); } }
          }
          { const int kk = i >> 1; const bf16x8 Ah = ldA(TDh, PK, 16 * i + r, kk, q), Al = ldA(TDl, PK, 16 * i + r, kk, q);
#pragma unroll
            for (int nt = 0; nt < 2; ++nt) { bf16x8 Bh, Bl; split2((i & 1) ? Z : R[i][nt], (i & 1) ? R[i][nt] : Z, Bh, Bl);
                f32x4 x = mfma16(Ah, Bh, Z); x = mfma16(Ah, Bl, x); x = mfma16(Al, Bh, x); X[i][nt] = x; } }
#ifndef CPU_EMU
            asm volatile("" ::: "memory");
#endif
      }
      bf16* U = (bf16*)(CWS + WS_U) + (size_t)ug * 8192; bf16* WN = (bf16*)(CWS + WS_WN) + (size_t)ug * 8192;
#pragma unroll
      for (int i = 0; i < 4; ++i)
#pragma unroll
        for (int nt = 0; nt < 2; ++nt)
#pragma unroll
            for (int jj = 0; jj < 4; ++jj) { const int t = 16 * i + 4 * q + jj, cc = n0 + 16 * nt + r; if (vpart) U[t * 128 + cc] = (bf16)f2bf(X[i][nt][jj]); else WN[t * 128 + cc] = (bf16)f2bf(-X[i][nt][jj]); }
    }
    __syncthreads();
}
DEV void phase_m1(Ctx& c, int layer) {
    int kside = 0; bool more = layer == 0;
    for (int u = c.bid; u < NU; u += c.G) {
        const int cid = u / NHT, hid = u % NHT;
        if (hid >= GLA_H && hid < GLA_H + GDN_H) m1_gdn(c, layer, cid, hid, hid - GLA_H);
        else { const bool is_gla = hid < GLA_H; m1_lin(c, layer, cid, hid, is_gla, is_gla ? hid : hid - GLA_H - GDN_H); }
        if (more) { more = conv_side(c, kside++); __syncthreads(); }
    }
    while (more) { more = conv_side(c, kside++); }
    __syncthreads();
    const bf16* PROJ = (const bf16*)(CWS + WS_PROJ);
    for (int i = c.bid * 512 + CTID; i < NSEQ * 3 * GDN_QKV; i += c.G * 512) {
        const int col = i % GDN_QKV, j = (i / GDN_QKV) % 3, sq_ = i / (3 * GDN_QKV);
        int row; float* dst;
        if (sq_ < BATCH) { row = sq_ * SEQ + SEQ - 3 + j; dst = COUT + O_PGC + (((size_t)layer * BATCH + sq_) * 3 + j) * GDN_QKV + col; }
        else { const int sb = sq_ - BATCH; row = MP + sb * DEC_SEQ + DEC_SEQ - 3 + j; dst = COUT + O_SGC + (((size_t)layer * DEC_BATCH + sb) * 3 + j) * GDN_QKV + col; }
        *dst = bf2f(PROJ[proj_row(row) + proj_col(C_DQ + col)]);
    }
}

DEV bf16x8 ldA(const bf16* base, int P, int row, int kk, int q) {
    const bf16* p = base + row * P + 32 * kk + 4 * q;
    const u32x2 lo = *(const u32x2*)p, hi = *(const u32x2*)(p + 16);
    u32x4 w; w.x = lo.x; w.y = lo.y; w.z = hi.x; w.w = hi.y; bf16x8 r; __builtin_memcpy(&r, &w, 16); return r;
}
DEV bf16x8 mkB(f32x4 x0, f32x4 x1) {
    u32x4 w; w.x = pk2(x0[0], x0[1]); w.y = pk2(x0[2], x0[3]); w.z = pk2(x1[0], x1[1]); w.w = pk2(x1[2], x1[3]); bf16x8 r; __builtin_memcpy(&r, &w, 16); return r;
}
struct M2Pre { u32x4 qb[2], wn[2], kbt[2], aq; float dl; float uv[16]; };
DEV void m2_item(Ctx& c, const bool GDN, int layer, int seq, int hid, int ugh  , int dv, int e_base  , int vcol  , int ocol  ,
                 const float* st_in, float* st_out) {
    constexpr int BUFB = 62976;
    int tid_ = CTID, wave_ = c.wave; LAUNDER_V(tid_); LAUNDER_S(wave_);
    const int tid = tid_, lane = tid & 63, q = lane >> 4, r = lane & 15, e0 = e_base + 16 * wave_;
    const bf16* PROJ = (const bf16*)(CWS + WS_PROJ); float* ORAW = (float*)(CWS + WS_ORAW);
    f32x4 S[8];
#pragma unroll
    for (int dt = 0; dt < 8; ++dt)
#pragma unroll
        for (int i = 0; i < 4; ++i) S[dt][i] = st_in ? st_in[(size_t)(16 * dt + 4 * q + i) * dv + e0 + r] : 0.f;
    const bool sample = seq >= BATCH; const int nch = sample ? 1 : CPS; const int cid0 = sample ? NCHP + (seq - BATCH) : seq * CPS;
    M2Pre P;
#define M2_LOAD(ch) do { const int cid_ = cid0 + (ch); const int u_ = rec_u(cid_, hid), ug_ = rec_ug(cid_, ugh); \
        const bf16* QB_ = (const bf16*)(CWS + WS_QB) + (size_t)u_ * 8192; const bf16* KBT_ = (const bf16*)(CWS + WS_KBT) + (size_t)u_ * 8192; const bf16* AQK_ = (const bf16*)(CWS + WS_AQK) + (size_t)u_ * 4096; \
        _Pragma("unroll") for (int k = 0; k < 2; ++k) { const int i = tid + 512 * k; P.qb[k] = *(const u32x4*)(QB_ + (i >> 4) * 128 + (i & 15) * 8); P.kbt[k] = *(const u32x4*)(KBT_ + (i >> 3) * 64 + (i & 7) * 8); } \
        P.aq = *(const u32x4*)(AQK_ + (tid >> 3) * 64 + (tid & 7) * 8); P.dl = ((const float*)(CWS + WS_DL))[(size_t)u_ * 128 + (tid & 127)]; \
        if (GDN) { const bf16* WN_ = (const bf16*)(CWS + WS_WN) + (size_t)ug_ * 8192; const bf16* U_ = (const bf16*)(CWS + WS_U) + (size_t)ug_ * 8192; \
            _Pragma("unroll") for (int k = 0; k < 2; ++k) { const int i = tid + 512 * k; P.wn[k] = *(const u32x4*)(WN_ + (i >> 4) * 128 + (i & 15) * 8); } \
            _Pragma("unroll") for (int j = 0; j < 16; ++j) P.uv[j] = bf2f(U_[(16 * (j >> 2) + 4 * q + (j & 3)) * 128 + e0 + r]); } \
        else { const Chunk ck_ = chunk_of(cid_); \
            _Pragma("unroll") for (int j = 0; j < 16; ++j) { const int t = 16 * (j >> 2) + 4 * q + (j & 3); const int tc = t < ck_.nvalid ? t : ck_.nvalid - 1; \
                const unsigned raw = (unsigned)PROJ[proj_row(ck_.row0 + tc) + proj_col(vcol + e0 + r)]; P.uv[j] = bf2f((bf16)(t < ck_.nvalid ? raw : 0u)); } } } while (0)
    M2_LOAD(0);
    for (int ch = 0; ch < nch; ++ch) {
        const Chunk ck = chunk_of(cid0 + ch);
        unsigned char* buf = c.lds + (ch & 1) * BUFB;
        bf16* QBs = (bf16*)buf; bf16* WNs = QBs + 64 * PA; bf16* KBTs = WNs + 64 * PA; bf16* AQs = KBTs + 128 * PK; float* DLs = (float*)(AQs + 64 * PK);
#pragma unroll
        for (int k = 0; k < 2; ++k) { const int i = tid + 512 * k; *(u32x4*)(QBs + (i >> 4) * PA + (i & 15) * 8) = P.qb[k]; *(u32x4*)(KBTs + (i >> 3) * PK + (i & 7) * 8) = P.kbt[k];
            if (GDN) *(u32x4*)(WNs + (i >> 4) * PA + (i & 15) * 8) = P.wn[k]; }
        *(u32x4*)(AQs + (tid >> 3) * PK + (tid & 7) * 8) = P.aq; if (tid < 128) DLs[tid] = P.dl;
        float cur[16];
#pragma unroll
        for (int j = 0; j < 16; ++j) cur[j] = P.uv[j];
        __syncthreads();
        if (ch + 1 < nch) M2_LOAD(ch + 1);
        bf16x8 Sf[4];
#pragma unroll
        for (int kk = 0; kk < 4; ++kk) Sf[kk] = mkB(S[2 * kk], S[2 * kk + 1]);
        bf16x8 Vf[2];
        if (GDN) {
            f32x4 vn[4];
#pragma unroll
            for (int h2 = 0; h2 < 2; ++h2) { bf16x8 fw[2][4];
#pragma unroll
                for (int t2 = 0; t2 < 2; ++t2)
#pragma unroll
                    for (int kk = 0; kk < 4; ++kk) fw[t2][kk] = ldA(WNs, PA, 16 * (2 * h2 + t2) + r, kk, q);
                SCHED_BAR();
                f32x4 v0 = (f32x4){cur[8 * h2], cur[8 * h2 + 1], cur[8 * h2 + 2], cur[8 * h2 + 3]}, v1 = (f32x4){cur[8 * h2 + 4], cur[8 * h2 + 5], cur[8 * h2 + 6], cur[8 * h2 + 7]};
#pragma unroll
                for (int kk = 0; kk < 4; ++kk) { v0 = mfma16(fw[0][kk], Sf[kk], v0); v1 = mfma16(fw[1][kk], Sf[kk], v1); }
                vn[2 * h2] = v0; vn[2 * h2 + 1] = v1;
                SCHED_BAR(); }
            Vf[0] = mkB(vn[0], vn[1]); Vf[1] = mkB(vn[2], vn[3]);
        } else {
            Vf[0] = mkB((f32x4){cur[0], cur[1], cur[2], cur[3]}, (f32x4){cur[4], cur[5], cur[6], cur[7]});
            Vf[1] = mkB((f32x4){cur[8], cur[9], cur[10], cur[11]}, (f32x4){cur[12], cur[13], cur[14], cur[15]});
        }
#pragma unroll
        for (int h2 = 0; h2 < 2; ++h2) {
            bf16x8 fq[2][4], fa[2][2];
#pragma unroll
            for (int t2 = 0; t2 < 2; ++t2) {
#pragma unroll
                for (int kk = 0; kk < 4; ++kk) fq[t2][kk] = ldA(QBs, PA, 16 * (2 * h2 + t2) + r, kk, q);
#pragma unroll
                for (int k2 = 0; k2 < 2; ++k2) fa[t2][k2] = ldA(AQs, PK, 16 * (2 * h2 + t2) + r, k2, q); }
            SCHED_BAR();
            f32x4 o0 = (f32x4){0.f, 0.f, 0.f, 0.f}, o1 = o0;
#pragma unroll
            for (int kk = 0; kk < 4; ++kk) { o0 = mfma16(fq[0][kk], Sf[kk], o0); o1 = mfma16(fq[1][kk], Sf[kk], o1); }
#pragma unroll
            for (int k2 = 0; k2 < 2; ++k2) { o0 = mfma16(fa[0][k2], Vf[k2], o0); o1 = mfma16(fa[1][k2], Vf[k2], o1); }
            {
#pragma unroll
                for (int t2 = 0; t2 < 2; ++t2) { const int tt = 2 * h2 + t2; const f32x4 o = t2 ? o1 : o0;
                    float* dst = (16 * tt < ck.nvalid) ? ORAW + (size_t)(ck.row0 + 16 * tt + 4 * q) * D_MIX + ocol + e0 + r : (float*)(CWS + WS_DMYROWS) + (size_t)(16 * tt + 4 * q) * D_MIX + ocol + e0 + r;
#pragma unroll
                    for (int i = 0; i < 4; ++i) dst[(size_t)i * D_MIX] = o[i]; } }
            SCHED_BAR();
        }
#pragma unroll
        for (int h4 = 0; h4 < 2; ++h4) {
            bf16x8 fk[4][2]; f32x4 dl[4];
#pragma unroll
            for (int d4 = 0; d4 < 4; ++d4) { dl[d4] = *(const f32x4*)(DLs + 16 * (4 * h4 + d4) + 4 * q);
#pragma unroll
                for (int k2 = 0; k2 < 2; ++k2) fk[d4][k2] = ldA(KBTs, PK, 16 * (4 * h4 + d4) + r, k2, q); }
            SCHED_BAR();
#pragma unroll
            for (int d4 = 0; d4 < 4; ++d4) S[4 * h4 + d4] = S[4 * h4 + d4] * dl[d4];
#pragma unroll
            for (int k2 = 0; k2 < 2; ++k2)
#pragma unroll
                for (int d4 = 0; d4 < 4; ++d4) S[4 * h4 + d4] = mfma16(fk[d4][k2], Vf[k2], S[4 * h4 + d4]);
            SCHED_BAR();
        }
    }
#undef M2_LOAD
#pragma unroll
    for (int dt = 0; dt < 8; ++dt)
#pragma unroll
        for (int i = 0; i < 4; ++i) st_out[(size_t)(16 * dt + 4 * q + i) * dv + e0 + r] = S[dt][i];
    __syncthreads();
}
DEV void phase_m2(Ctx& c, int layer) {
    constexpr int NLONG_ = BATCH * NCG, NALL_ = NSEQ * NCG;
    const int step_ = c.G > NLONG_ ? (c.bid < NLONG_ ? NALL_ : c.G - NLONG_) : c.G;
    for (int it = c.bid; it < NALL_; it += step_) {
        const int seq = it / NCG, g = it % NCG;
        const bool sample = seq >= BATCH; const int sb = seq - BATCH;
        int hid, ugh = 0, dv, e_base = 0, vcol = 0, ocol; bool gdn = false; size_t so_p, so_s, hstride; const float* sin_base;
        if (g < 2 * GLA_H) { const int h = g >> 1; hid = h; dv = GLA_DV; e_base = (g & 1) * 128; vcol = C_GV + h * GLA_DV; ocol = h * GLA_DV;
            hstride = (size_t)DK * GLA_DV; sin_base = c.in[I_SGLA]; so_p = O_PGLA + ((size_t)layer * BATCH + seq) * GLA_H * hstride + h * hstride; so_s = O_SGLA + ((size_t)layer * DEC_BATCH + sb) * GLA_H * hstride + h * hstride;
            sin_base += ((size_t)layer * DEC_BATCH + sb) * GLA_H * hstride + h * hstride; }
        else if (g < 2 * GLA_H + GDN_H) { const int h = g - 2 * GLA_H; hid = GLA_H + h; ugh = h; gdn = true; dv = GDN_DV; ocol = GLA_VW + h * GDN_DV;
            hstride = (size_t)DK * GDN_DV; sin_base = c.in[I_SGDN]; so_p = O_PGDN + ((size_t)layer * BATCH + seq) * GDN_H * hstride + h * hstride; so_s = O_SGDN + ((size_t)layer * DEC_BATCH + sb) * GDN_H * hstride + h * hstride;
            sin_base += ((size_t)layer * DEC_BATCH + sb) * GDN_H * hstride + h * hstride; }
        else { const int h = g - 2 * GLA_H - GDN_H; hid = GLA_H + GDN_H + h; dv = HG_DV; vcol = C_HI + h * HG_DV; ocol = GLA_VW + GDN_VW + h * HG_DV;
            hstride = (size_t)DK * HG_DV; sin_base = c.in[I_SHG]; so_p = O_PHG + ((size_t)layer * BATCH + seq) * HG_H * hstride + h * hstride; so_s = O_SHG + ((size_t)layer * DEC_BATCH + sb) * HG_H * hstride + h * hstride;
            sin_base += ((size_t)layer * DEC_BATCH + sb) * HG_H * hstride + h * hstride; }
        m2_item(c, gdn, layer, seq, hid, ugh, dv, e_base, vcol, ocol, sample ? sin_base : nullptr, COUT + (sample ? so_s : so_p));
    }
    {
        constexpr int NLONG = BATCH * NCG; const int first = c.G > NLONG ? NLONG : 0;
        if (c.bid >= first) conv_wup(c, layer, (c.bid - first) * 8 + c.wave, (c.G - first) * 8);
    }
}

DEV float half_sum(float v) {
#pragma unroll
    for (int o = 1; o < 32; o <<= 1) v += SHFL_XOR(v, o);
    return v;
}
DEV void phase_m3(Ctx& c, int layer) {
    static_assert(GLA_DV == 256 && GDN_DV == 128 && HG_DV == 128 && GLA_VW % 256 == 0 && GDN_VW % 256 == 0, "256-column blocks never straddle mixers");
    constexpr int NJ = (D_MIX + 255) / 256;
    int tid_ = CTID, wave_ = c.wave; LAUNDER_V(tid_); LAUNDER_S(wave_);
    const int gw = c.bid * 8 + wave_, NGW = c.G * 8, lane = tid_ & 63;
    const bf16* PROJ = (const bf16*)(CWS + WS_PROJ); const float* ORAW = (const float*)(CWS + WS_ORAW); bf16* OB = (bf16*)(CWS + WS_OB);
    const f32x4 w_gla = *(const f32x4*)(c.in[I_GLAN] + (size_t)layer * GLA_DV + 4 * lane), w_gdn = *(const f32x4*)(c.in[I_GDNN] + (size_t)layer * GDN_DV + 4 * (lane & 31)), w_hg = *(const f32x4*)(c.in[I_HGN] + (size_t)layer * HG_DV + 4 * (lane & 31));
    for (int row = gw; row < M; row += NGW) {
        const float* orow = ORAW + (size_t)row * D_MIX; const bf16* prow = PROJ + proj_row(row); bf16* dst = OB + (size_t)row * D_MIX;
        f32x4 ov[NJ]; u32x2 gv[NJ];
#pragma unroll
        for (int j = 0; j < NJ; ++j) { const int col = 256 * j + 4 * lane; const bool in = col < D_MIX;
            const int gcol = col < GLA_VW ? C_GG + col : col < GLA_VW + GDN_VW ? C_DZ + (col - GLA_VW) : C_HG + (col - GLA_VW - GDN_VW);
            ov[j] = in ? *(const f32x4*)(orow + col) : (f32x4){0.f, 0.f, 0.f, 0.f}; gv[j] = in ? *(const u32x2*)(prow + proj_col(gcol)) : (u32x2){0u, 0u}; }
#pragma unroll
        for (int j = 0; j < NJ; ++j) { const int col = 256 * j + 4 * lane; const f32x4 v = ov[j];
            float ss = (v[0] * v[0] + v[1] * v[1]) + (v[2] * v[2] + v[3] * v[3]); float rs; f32x4 w;
            if (256 * j < GLA_VW) { ss = wave_sum(ss); rs = FRSQ(ss * (1.0f / GLA_DV) + EPS); w = w_gla; }
            else { ss = half_sum(ss); rs = FRSQ(ss * (1.0f / GDN_DV) + EPS); w = (256 * j < GLA_VW + GDN_VW) ? w_gdn : w_hg; }
            const f32x4 g = unpack4(gv[j]);
            u32x2 o; o.x = pk2(v[0] * rs * w[0] * siluf_(g[0]), v[1] * rs * w[1] * siluf_(g[1])); o.y = pk2(v[2] * rs * w[2] * siluf_(g[2]), v[3] * rs * w[3] * siluf_(g[3]));
            if (col < D_MIX) *(u32x2*)(dst + col) = o; }
    }
}

DEV void unpack8(const u32x4 a, float (&x)[8]) { const unsigned w[4] = {a.x, a.y, a.z, a.w};
#pragma unroll
    for (int e = 0; e < 4; ++e) { x[2 * e] = bf2f((bf16)(w[e] & 0xffff)); x[2 * e + 1] = bf2f((bf16)(w[e] >> 16)); } }
DEV void phase_f1(Ctx& c, int layer) {
    const bf16* UP = (const bf16*)(CWS + WS_UP); bf16* ACT = (bf16*)(CWS + WS_ACT); const bf16* SIDE = (const bf16*)(CWS + WS_SIDE);
    const float* wf = c.in[I_WFC] + (size_t)layer * FCONV * NUP;
    constexpr int CG = D_FF / 8, RB = 8, NRB = MS / RB;
    static_assert(SEQ % 64 == 0 && DEC_SEQ % RB == 0 && FCONV == 3 && MP % 256 == 0, "row blocks never straddle sequences");
    int tid_ = CTID; LAUNDER_V(tid_);
    for (size_t it = (size_t)c.bid * 512 + tid_; it < (size_t)NRB * CG; it += (size_t)c.G * 512) {
        const int c0 = (int)(it % CG) * 8, row0 = MP + (int)(it / CG) * RB;
        const int pos0 = (row0 - MP) % DEC_SEQ, sb = (row0 - MP) / DEC_SEQ;
        float wg[3][8], wv[3][8];
#pragma unroll
        for (int j = 0; j < 3; ++j) { const f32x4 a = *(const f32x4*)(wf + (size_t)j * NUP + c0), b = *(const f32x4*)(wf + (size_t)j * NUP + c0 + 4), d = *(const f32x4*)(wf + (size_t)j * NUP + D_FF + c0), e = *(const f32x4*)(wf + (size_t)j * NUP + D_FF + c0 + 4);
#pragma unroll
            for (int k = 0; k < 4; ++k) { wg[j][k] = a[k]; wg[j][4 + k] = b[k]; wv[j][k] = d[k]; wv[j][4 + k] = e[k]; } }
        float g2[8], g1[8], v2[8], v1[8];
        if (pos0 > 0) { const bf16* p2 = UP + (size_t)(row0 - 2) * NUP + c0; unpack8(*(const u32x4*)p2, g2); unpack8(*(const u32x4*)(p2 + D_FF), v2); unpack8(*(const u32x4*)(p2 + NUP), g1); unpack8(*(const u32x4*)(p2 + NUP + D_FF), v1); }
        else { const float* cr = c.in[I_CFFN] + ((size_t)layer * DEC_BATCH + sb) * (FCONV - 1) * NUP + c0;
#pragma unroll
            for (int e = 0; e < 8; ++e) { g2[e] = cr[e]; v2[e] = cr[D_FF + e]; g1[e] = cr[NUP + e]; v1[e] = cr[NUP + D_FF + e]; } }
#pragma unroll 1
        for (int i0 = 0; i0 < RB; i0 += 8) {
            u32x4 ra[8], rv[8];
#pragma unroll
            for (int i = 0; i < 8; ++i) { const bf16* pr = UP + (size_t)(row0 + i0 + i) * NUP + c0; ra[i] = *(const u32x4*)pr; rv[i] = *(const u32x4*)(pr + D_FF); }
#pragma unroll
            for (int i = 0; i < 8; ++i) { float xg[8], xv[8], o[8]; unpack8(ra[i], xg); unpack8(rv[i], xv);
#pragma unroll
                for (int e = 0; e < 8; ++e) { const float ga = wg[0][e] * g2[e] + wg[1][e] * g1[e] + wg[2][e] * xg[e], va = wv[0][e] * v2[e] + wv[1][e] * v1[e] + wv[2][e] * xv[e];
                    o[e] = siluf_(ga) * va; g2[e] = g1[e]; g1[e] = xg[e]; v2[e] = v1[e]; v1[e] = xv[e]; }
                u32x4 w; w.x = pk2(o[0], o[1]); w.y = pk2(o[2], o[3]); w.z = pk2(o[4], o[5]); w.w = pk2(o[6], o[7]);
                *(u32x4*)(ACT + (size_t)(row0 + i0 + i) * D_FF + c0) = w; }
        }
    }
    constexpr int NBLK = MP / 64, BPS = SEQ / 64;
    for (size_t it = (size_t)c.bid * 512 + tid_; it < (size_t)NBLK * CG; it += (size_t)c.G * 512) {
        const int c0 = (int)(it % CG) * 8, B = (int)(it / CG);
        if (B % BPS == 0) continue;
        float wg[3][8], wv[3][8];
#pragma unroll
        for (int j = 0; j < 3; ++j) { const f32x4 a = *(const f32x4*)(wf + (size_t)j * NUP + c0), b = *(const f32x4*)(wf + (size_t)j * NUP + c0 + 4), d = *(const f32x4*)(wf + (size_t)j * NUP + D_FF + c0), e = *(const f32x4*)(wf + (size_t)j * NUP + D_FF + c0 + 4);
#pragma unroll
            for (int k = 0; k < 4; ++k) { wg[j][k] = a[k]; wg[j][4 + k] = b[k]; wv[j][k] = d[k]; wv[j][4 + k] = e[k]; } }
        const bf16* sa = SIDE + ((size_t)(B - 1) * 4 + 2) * NUP + c0; const bf16* sb_ = SIDE + (size_t)B * 4 * NUP + c0;
        float gm2[8], gm1[8], g0[8], gp1[8], vm2[8], vm1[8], v0[8], vp1[8];
        unpack8(*(const u32x4*)sa, gm2); unpack8(*(const u32x4*)(sa + NUP), gm1); unpack8(*(const u32x4*)sb_, g0); unpack8(*(const u32x4*)(sb_ + NUP), gp1);
        unpack8(*(const u32x4*)(sa + D_FF), vm2); unpack8(*(const u32x4*)(sa + NUP + D_FF), vm1); unpack8(*(const u32x4*)(sb_ + D_FF), v0); unpack8(*(const u32x4*)(sb_ + NUP + D_FF), vp1);
        float o0[8], o1[8];
#pragma unroll
        for (int e = 0; e < 8; ++e) {
            o0[e] = siluf_(wg[0][e] * gm2[e] + wg[1][e] * gm1[e] + wg[2][e] * g0[e]) * (wv[0][e] * vm2[e] + wv[1][e] * vm1[e] + wv[2][e] * v0[e]);
            o1[e] = siluf_(wg[0][e] * gm1[e] + wg[1][e] * g0[e] + wg[2][e] * gp1[e]) * (wv[0][e] * vm1[e] + wv[1][e] * v0[e] + wv[2][e] * vp1[e]); }
        u32x4 w; w.x = pk2(o0[0], o0[1]); w.y = pk2(o0[2], o0[3]); w.z = pk2(o0[4], o0[5]); w.w = pk2(o0[6], o0[7]); *(u32x4*)(ACT + act_off(64 * B, c0)) = w;
        w.x = pk2(o1[0], o1[1]); w.y = pk2(o1[2], o1[3]); w.z = pk2(o1[4], o1[5]); w.w = pk2(o1[6], o1[7]); *(u32x4*)(ACT + act_off(64 * B + 1, c0)) = w;
    }
    for (int i = c.bid * 512 + CTID; i < NSEQ * 2 * NUP; i += c.G * 512) {
        const int col = i % NUP, j = (i / NUP) % 2, sq_ = i / (2 * NUP);
        if (sq_ < BATCH) COUT[O_PFC + (((size_t)layer * BATCH + sq_) * 2 + j) * NUP + col] = bf2f(SIDE[((size_t)(BPS * (sq_ + 1) - 1) * 4 + 2 + j) * NUP + col]);
        else { const int sb = sq_ - BATCH; COUT[O_SFC + (((size_t)layer * DEC_BATCH + sb) * 2 + j) * NUP + col] = bf2f(UP[(size_t)(MP + sb * DEC_SEQ + DEC_SEQ - 2 + j) * NUP + col]); }
    }
}

struct SkSet { u32x4 a0, a1, b0, b1; };
template <int MODE  >
DEV void skinny_phase(Ctx& c, const bf16* A, const bf16* Bt, int N, int K, const bf16* Rin, bf16* Rout, const bf16* Gm, int ldc, ssq_t* ssout, const ssq_t* ssin) {
    static_assert(MS % 64 == 0, "64-row tiles");
    int tid_ = CTID, wave_ = c.wave; LAUNDER_V(tid_); LAUNDER_S(wave_);
    const int tid = tid_, lane = tid & 63, q = lane >> 4, r = lane & 15, wr = wave_ >> 2, wc = wave_ & 3;
    bf16* As = (bf16*)c.lds; bf16* Bs = As + 2 * 64 * PA;
    const int srow = tid >> 4, sc16 = tid & 15;
    const int nit = K / 128;
    for (int item = c.bid; item < (MS / 64) * (N / 64); item += c.G) {
        const int rb = item % (MS / 64), cb = item / (MS / 64);
        const bf16* ga = A + (size_t)(rb * 64 + srow) * K + sc16 * 8; const bf16* gb = Bt + (size_t)(cb * 64 + srow) * K + sc16 * 8; const size_t r32 = (size_t)32 * K;
        f32x4 acc0 = (f32x4){0.f, 0.f, 0.f, 0.f}, acc1 = acc0;
        SkSet R0, R1, R2;
#define SK_LOAD(R, t) do { const int ko_ = (t) * 128; R.a0 = *(const u32x4*)(ga + ko_); R.a1 = *(const u32x4*)(ga + r32 + ko_); R.b0 = *(const u32x4*)(gb + ko_); R.b1 = *(const u32x4*)(gb + r32 + ko_); } while (0)
#define SK_STEP(R, t) do { if ((t) < nit) { bf16* as_ = As + ((t) & 1) * 64 * PA; bf16* bs_ = Bs + ((t) & 1) * 64 * PA; \
            *(u32x4*)(as_ + srow * PA + sc16 * 8) = R.a0; *(u32x4*)(as_ + (srow + 32) * PA + sc16 * 8) = R.a1; *(u32x4*)(bs_ + srow * PA + sc16 * 8) = R.b0; *(u32x4*)(bs_ + (srow + 32) * PA + sc16 * 8) = R.b1; \
            __syncthreads(); \
            if ((t) + 3 < nit) SK_LOAD(R, (t) + 3); \
            _Pragma("unroll") for (int kk = 0; kk < 4; ++kk) { const bf16x8 bfr = ldF(bs_ + (16 * wc + r) * PA + 32 * kk + 8 * q); \
                acc0 = mfma16(bfr, ldF(as_ + (32 * wr + r) * PA + 32 * kk + 8 * q), acc0); acc1 = mfma16(bfr, ldF(as_ + (32 * wr + 16 + r) * PA + 32 * kk + 8 * q), acc1); } } } while (0)
        SK_LOAD(R0, 0); if (1 < nit) SK_LOAD(R1, 1); if (2 < nit) SK_LOAD(R2, 2);
#pragma unroll 1
        for (int t = 0; t < nit; t += 3) { SK_STEP(R0, t); SK_STEP(R1, t + 1); SK_STEP(R2, t + 2); }
#undef SK_LOAD
#undef SK_STEP
#pragma unroll
        for (int mt = 0; mt < 2; ++mt) { const f32x4 v = mt ? acc1 : acc0; const int row = MP + rb * 64 + 32 * wr + 16 * mt + r; const size_t off = (size_t)row * ldc + cb * 64 + 16 * wc + 4 * q;
            f32x4 o = unpack4(*(const u32x2*)(Rin + off));
            if (MODE == 1) o = o + v;
            if (MODE == 2) { const f32x4 g = unpack4(*(const u32x2*)(Gm + off)); const float rs = rstd_of(ssin, row);
                o = (f32x4){o[0] + sigmoidf_(v[0] * rs) * g[0], o[1] + sigmoidf_(v[1] * rs) * g[1], o[2] + sigmoidf_(v[2] * rs) * g[2], o[3] + sigmoidf_(v[3] * rs) * g[3]}; }
            { u32x2 w; w.x = pk2(o[0], o[1]); w.y = pk2(o[2], o[3]); *(u32x2*)(Rout + off) = w; const f32x4 vr = unpack4(w); float sq = (vr[0] * vr[0] + vr[1] * vr[1]) + (vr[2] * vr[2] + vr[3] * vr[3]);
              sq += SHFL_XOR(sq, 16); sq += SHFL_XOR(sq, 32); if (q == 0) atomic_addf(ssout + row, sq); } }
        __syncthreads();
    }
}

#ifndef SKIP_MIN_G
#define SKIP_MIN_G 64
#endif
constexpr int PPL = 9, NPHASE = 2 + PPL * DEPTH;
#ifndef REP_PRO
#define REP_PRO 1
#endif
#ifndef REP_GEMM
#define REP_GEMM 1
#endif
#ifndef REP_MIX
#define REP_MIX 1
#endif
#ifndef REP_MISC
#define REP_MISC 1
#endif
#ifndef REP_SK
#define REP_SK REP_GEMM
#endif
#ifndef REP_M1
#define REP_M1 REP_MIX
#endif
#ifndef REP_M2
#define REP_M2 REP_MIX
#endif
#ifndef REP_M3
#define REP_M3 REP_MIX
#endif
#ifndef CPU_EMU
#define XB_TMO      128
#define XB_XCNT(j)  (256  + 64 * (j))
#define XB_XSUB(j)  (1280 + 64 * (j))
#define XB_XGEN(j)  (2304 + 64 * (j))
#define XB_TOP      3328
#define XB_TOPGEN   3392
#define XCD_BAR_WORDS 3456
#define XB_SPIN_CAP (1u << 18)

__device__ __forceinline__ unsigned xb_ld(unsigned* p)              { return __hip_atomic_load(p, __ATOMIC_RELAXED, __HIP_MEMORY_SCOPE_AGENT); }
__device__ __forceinline__ unsigned xb_add(unsigned* p, unsigned v) { return __hip_atomic_fetch_add(p, v, __ATOMIC_RELAXED, __HIP_MEMORY_SCOPE_AGENT); }
__device__ __forceinline__ unsigned xb_xcc_id() { return (unsigned)__builtin_amdgcn_s_getreg((3 << 11) | 20) & 0xFu; }
#define XB_SPIN(cond, bar) do { unsigned _sp = 0; while (cond) { __builtin_amdgcn_s_sleep(1); \
    if ((++_sp & 255u) == 0u) { if (xb_ld(&(bar)[XB_TMO])) break; if (_sp > XB_SPIN_CAP) { atomicAdd(&(bar)[XB_TMO], 1u); break; } } } } while (0)

struct XcdBarrier {
    unsigned* bar; unsigned x;
    volatile LAS unsigned* st;
    bool t0;
};

__device__ __forceinline__ XcdBarrier xcd_barrier_post(unsigned* bar, volatile LAS unsigned* st) {
    XcdBarrier b; b.bar = bar; b.x = xb_xcc_id(); b.st = st; b.t0 = threadIdx.x == 0;
    if (b.t0) (void)xb_add(&bar[XB_XCNT(b.x)], 1u);
    return b;
}
__device__ __forceinline__ void xcd_barrier_complete(unsigned* bar, unsigned x, unsigned& nloc, unsigned& nx) {
    const unsigned G = gridDim.x * gridDim.y * gridDim.z;
    unsigned sum, cnt, mine, sp = 0u;
    for (;;) {
        sum = 0u; cnt = 0u; mine = 0u;
#pragma unroll
        for (unsigned j = 0; j < 16; ++j) { const unsigned c = xb_ld(&bar[XB_XCNT(j)]); sum += c; cnt += (c > 0u) ? 1u : 0u; mine = (j == x) ? c : mine; }
        if (sum == G) break;
        __builtin_amdgcn_s_sleep(1);
        if ((++sp & 255u) == 0u) { if (xb_ld(&bar[XB_TMO])) break; if (sp > XB_SPIN_CAP) { atomicAdd(&bar[XB_TMO], 1u); break; } }
    }
    nloc = mine > 0u ? mine : 1u; nx = cnt > 0u ? cnt : 1u;
}

__device__ __forceinline__ void xcd_barrier(const XcdBarrier& b) {
    asm volatile("s_waitcnt vmcnt(0)" ::: "memory");
    __syncthreads();
    if (b.t0) {
        unsigned* bar = b.bar;
        __builtin_amdgcn_s_waitcnt(0);
        unsigned nloc = b.st[0], nx = b.st[1];
        if (nloc == 0u) { xcd_barrier_complete(bar, b.x, nloc, nx); b.st[0] = nloc; b.st[1] = nx; }
        const unsigned old = xb_add(&bar[XB_XSUB(b.x)], 1u);
        const unsigned gen = old / nloc;
        if (old + 1u == (gen + 1u) * nloc) {
            __builtin_amdgcn_fence(__ATOMIC_RELEASE, "agent");
            asm volatile("s_waitcnt vmcnt(0)" ::: "memory");
            const unsigned og = xb_add(&bar[XB_TOP], 1u);
            const unsigned tg = og / nx;
            if (og + 1u == (tg + 1u) * nx) xb_add(&bar[XB_TOPGEN], 1u);
            else XB_SPIN(xb_ld(&bar[XB_TOPGEN]) == tg, bar);
            __builtin_amdgcn_fence(__ATOMIC_ACQUIRE, "agent");
            xb_add(&bar[XB_XGEN(b.x)], 1u);
            asm volatile("s_waitcnt vmcnt(0)" ::: "memory");
        } else {
            XB_SPIN(xb_ld(&bar[XB_XGEN(b.x)]) == gen, bar);
            __builtin_amdgcn_fence(__ATOMIC_ACQUIRE, "agent");
            asm volatile("s_waitcnt vmcnt(0)" ::: "memory");
        }
    }
    __syncthreads();
}

#define GRID_BAR() do { XcdBarrier bar_; bar_.bar = (unsigned*)(CWS + WS_CTL) + CW_BAR; bar_.x = xb_xcc_id(); bar_.t0 = c.wave == 0 && lane_id_() == 0; bar_.st = (volatile LAS unsigned*)((LAS unsigned char*)c.lds_raw_ + (163840 - 256)) + 8; xcd_barrier(bar_); } while (0)
#else
#define GRID_BAR() do {} while (0)
#endif

struct Args { const float* in[29]; float* out; unsigned char* ws; int ph_lo, ph_hi; };
static_assert(sizeof(void*) == 8 && __builtin_offsetof(Args, out) == 29 * 8 && __builtin_offsetof(Args, ws) == 30 * 8, "CWS / COUT read Args through the in[] table");
#ifndef CPU_EMU
#define BAR_PARAM
#define BAR_ARG
#define LDSP ((PG8_LAS unsigned char*)c.lds_raw_)
#else
#define BAR_PARAM
#define BAR_ARG
#define LDSP (c.lds)
#endif
#define IN(k) (lo <= (k) && (k) < hi)
#ifndef REP_BAR
#define REP_BAR 1
#endif
#define SEAM(k) do { if (IN(k) && IN((k) + 1)) { GRID_BAR(); if (REP_BAR > 1) GRID_BAR(); } } while (0)
template <int l>
DEV void layer_program(Ctx& c, const int lo, const int hi BAR_PARAM) {
        constexpr int pb = 1 + PPL * l;
        ssq_t* const SS = (ssq_t*)(CWS + WS_SS);
        bf16* const Ra = (bf16*)(CWS + ((l & 1) ? WS_XB1 : WS_XN)); bf16* const Rb = (bf16*)(CWS + ((l & 1) ? WS_XN : WS_XB1));
        if (IN(pb + 0)) {
            pg8::Gemm g{Ra, (const bf16*)(CWS + WS_WIN + l * al4k(SZ_WIN)), M, N1, D_MODEL}; pg8::StaticOrder S; S.init(M, N1, c.G, c.bid); S.wv = c.wave;
            EpiProj E{(bf16*)(CWS + WS_PROJ), (float*)(CWS + WS_PSM), SS + (size_t)(3 * l) * M};
            for (int rep = 0; rep < REP_GEMM; ++rep) pg8::gemm_phase<EpiProj, pg8::StaticOrder, PG8_ALIGN, PG8_SP2>(LDSP, g, S, E);
            {
                const int nwg = (M / 256) * (N1 / 256), rem = nwg % c.G;
                if (c.bid >= rem) { conv_wout(c, l, (c.bid - rem) * 8 + c.wave, (c.G - rem) * 8); conv_wpg(c, l, (c.bid - rem) * 8 + c.wave, (c.G - rem) * 8); }
            }
        }
        SEAM(pb + 0);
        if (IN(pb + 1)) { phase_m1(c, l); if (REP_M1 > 1) phase_m1(c, l); }
        SEAM(pb + 1);
        if (IN(pb + 2)) { phase_m2(c, l); if (REP_M2 > 1) phase_m2(c, l); }
        SEAM(pb + 2);
        if (IN(pb + 3)) { phase_m3(c, l); if (REP_M3 > 1) phase_m3(c, l); }
        SEAM(pb + 3);
        if (IN(pb + 4)) {
            pg8::Gemm g{(const bf16*)(CWS + WS_OB), (const bf16*)(CWS + WS_WOUT + l * al4k(SZ_WOUT)), MP, D_MODEL, D_MIX}; pg8::StaticOrder S; S.init(MP, D_MODEL, c.G, c.bid); S.wv = c.wave;
            EpiRes<1> E{Ra, Ra, D_MODEL, nullptr, SS + (size_t)(3 * l + 1) * M, nullptr};
            pg8::gemm_phase<EpiRes<1>, pg8::StaticOrder, PG8_ALIGN, PG8_SP2>(LDSP, g, S, E);
            skinny_phase<1>(c, (const bf16*)(CWS + WS_OB) + (size_t)MP * D_MIX, (const bf16*)(CWS + WS_WOUT + l * al4k(SZ_WOUT)), D_MODEL, D_MIX, Ra, Ra, nullptr, D_MODEL, SS + (size_t)(3 * l + 1) * M, nullptr);
        }
        SEAM(pb + 4);
        if (IN(pb + 5)) {
            { pg8::Gemm g{Ra, (const bf16*)(CWS + WS_WUP + l * al4k(SZ_WUP)), M, NUP, D_MODEL}; pg8::StaticOrder S; S.init(M, NUP, c.G, c.bid); S.wv = c.wave;
              EpiUpAct<l> E{c.in};
              for (int rep = 0; rep < REP_GEMM; ++rep) pg8::gemm_phase<EpiUpAct<l>, pg8::StaticOrder, PG8_ALIGN, PG8_SP2>(LDSP, g, S, E); }
            {
              const int rem3 = ((M / 256) * (NUP / 256)) % c.G, skip = (rem3 && c.G - ((rem3 + 7) & ~7) >= SKIP_MIN_G) ? ((rem3 + 7) & ~7) : 0;
              if (c.bid >= skip) {
              pg8::Gemm g{(const bf16*)(CWS + WS_PE) + (size_t)l * M * D_PLE, (const bf16*)(CWS + WS_WPP + l * al4k(SZ_WPP)), M, D_MODEL, D_PLE}; pg8::StaticOrder S; S.init(M, D_MODEL, c.G - skip, c.bid - skip); S.wv = c.wave;
              EpiBf16Out E{(bf16*)(CWS + WS_PP), D_MODEL, nullptr};
              for (int rep = 0; rep < REP_GEMM; ++rep) pg8::gemm_phase<EpiBf16Out, pg8::StaticOrder, PG8_ALIGN, PG8_SP2>(LDSP, g, S, E); } }
            {
                const int nwg = (M / 256) * (NUP / 256), rem = nwg % c.G, first = rem ? rem : 0;
                if (c.bid >= first) { const int gw_ = (c.bid - first) * 8 + c.wave, ngw_ = (c.G - first) * 8; conv_wdn(c, l, gw_, ngw_); }
            }
        }
        SEAM(pb + 5);
        if (IN(pb + 6)) for (int rep = 0; rep < REP_MISC; ++rep) phase_f1(c, l);
        SEAM(pb + 6);
        if (IN(pb + 7)) {
            pg8::Gemm g{(const bf16*)(CWS + WS_ACT), (const bf16*)(CWS + WS_WDN + l * al4k(SZ_WDN)), MP, D_MODEL, D_FF}; pg8::StaticOrder S; S.init(MP, D_MODEL, c.G, c.bid); S.wv = c.wave;
            EpiRes<1, true> E{Ra, Ra, D_MODEL, nullptr, SS + (size_t)(3 * l + 2) * M, nullptr};
            pg8::gemm_phase<EpiRes<1, true>, pg8::StaticOrder, PG8_ALIGN, PG8_SP2>(LDSP, g, S, E);
            skinny_phase<1>(c, (const bf16*)(CWS + WS_ACT) + (size_t)MP * D_FF, (const bf16*)(CWS + WS_WDN + l * al4k(SZ_WDN)), D_MODEL, D_FF, Ra, Ra, nullptr, D_MODEL, SS + (size_t)(3 * l + 2) * M, nullptr);
        }
        SEAM(pb + 7);
        if (IN(pb + 8)) {
            pg8::Gemm g{Ra, (const bf16*)(CWS + WS_WPG + l * al4k(SZ_WPG)), MP, D_MODEL, D_MODEL}; pg8::StaticOrder S; S.init(MP, D_MODEL, c.G, c.bid); S.wv = c.wave;
            EpiRes<2> E{Ra, Rb, D_MODEL, (const bf16*)(CWS + WS_PP), SS + (size_t)(3 * l + 3) * M, SS + (size_t)(3 * l + 2) * M};
            pg8::gemm_phase<EpiRes<2>, pg8::StaticOrder, PG8_ALIGN, PG8_SP2>(LDSP, g, S, E);
            skinny_phase<2>(c, Ra + (size_t)MP * D_MODEL, (const bf16*)(CWS + WS_WPG + l * al4k(SZ_WPG)), D_MODEL, D_MODEL, Ra, Rb, (const bf16*)(CWS + WS_PP), D_MODEL, SS + (size_t)(3 * l + 3) * M, SS + (size_t)(3 * l + 2) * M);
        }
        SEAM(pb + 8);
}

#ifdef CPU_EMU
static void fwd_body(const Args& args)
#else
__global__ void __launch_bounds__(512, 2) fwd(Args args)
#endif
{
    Ctx c;
#ifdef CPU_EMU
    c.lds = cpu::g_lds;
    c.wave = (int)threadIdx.x >> 6;
#else
    extern __shared__ __attribute__((aligned(16))) unsigned char lds_raw[];
    c.lds = lds_raw; c.lds_raw_ = lds_raw;
    c.wave = __builtin_amdgcn_readfirstlane((int)threadIdx.x >> 6);
#endif
    c.G = gridDim.x; c.bid = blockIdx.x;
    c.in = args.in;
#ifndef CPU_EMU
    volatile LAS unsigned* MISC = (volatile LAS unsigned*)((LAS unsigned char*)lds_raw + (163840 - 256));
    if (CTID < 32) MISC[CTID] = 0u;
    __syncthreads();
    (void)xcd_barrier_post((unsigned*)(args.ws + WS_CTL) + CW_BAR, MISC + 8);
#endif
    const int lo = args.ph_lo, hi = args.ph_hi;
    static_assert(DEPTH == 2, "layer_program is instantiated twice");
    if (IN(0)) for (int rep = 0; rep < REP_PRO; ++rep) phase_prologue(c);
    SEAM(0);
    layer_program<0>(c, lo, hi BAR_ARG);
    layer_program<1>(c, lo, hi BAR_ARG);
    if (IN(1 + PPL * DEPTH)) phase_final(c);
}

#ifndef CPU_EMU
#ifndef MK_PER_PHASE
#define MK_PER_PHASE 0
#endif
constexpr int LDS_BYTES = 163840;
extern "C" void kernel_launch(void* const* d_in, const int* in_sizes, int n_in, void* d_out, int out_size, void* d_ws, size_t ws_size, hipStream_t stream) {
    static int grid = 0;
    if (grid == 0) {
        if (n_in != 29 || (size_t)out_size != OUT_TOTAL || ws_size < WS_END) { fprintf(stderr, "kernel_launch: unexpected shapes: n_in %d out %d (want %zu) ws %zu (want %zu)\n", n_in, out_size, (size_t)OUT_TOTAL, ws_size, (size_t)WS_END); grid = -1; return; }
        int dev = 0, cus = 0, per_cu = 0;
        if (hipGetDevice(&dev) != hipSuccess || hipDeviceGetAttribute(&cus, hipDeviceAttributeMultiprocessorCount, dev) != hipSuccess) { grid = -1; return; }
        if (hipFuncSetAttribute((const void*)fwd, hipFuncAttributeMaxDynamicSharedMemorySize, LDS_BYTES) != hipSuccess) { fprintf(stderr, "kernel_launch: hipFuncSetAttribute failed\n"); grid = -1; return; }
        if (hipOccupancyMaxActiveBlocksPerMultiprocessor(&per_cu, (const void*)fwd, 512, LDS_BYTES) != hipSuccess || per_cu < 1) fprintf(stderr, "kernel_launch: occupancy query says %d\n", per_cu);
        (void)hipGetLastError();
        grid = cus;
    }
    if (grid < 0) return;
    static_assert((CW_BAR + XCD_BAR_WORDS) * 4 <= 32768, "barrier words inside the zeroed bytes");
    if (hipMemsetAsync((char*)d_ws + WS_CTL, 0, 32768, stream) != hipSuccess) return;
    Args a{};
    for (int i = 0; i < 29; ++i) a.in[i] = (const float*)d_in[i];
    a.out = (float*)d_out; a.ws = (unsigned char*)d_ws;
#if MK_PER_PHASE
    for (int p = 0; p < NPHASE; ++p) { a.ph_lo = p; a.ph_hi = p + 1; hipLaunchKernelGGL(fwd, dim3(grid), dim3(512), LDS_BYTES, stream, a); }
#else
    a.ph_lo = 0; a.ph_hi = NPHASE; hipLaunchKernelGGL(fwd, dim3(grid), dim3(512), LDS_BYTES, stream, a);
#endif
}
#endif
```
